# Optimizing an MI355X kernel written in HIP

```python
import math
import jax, jax.numpy as jnp
from jax import lax
import numpy as np

D_MODEL = 1024
BATCH = 4
SEQ = 8192
DEPTH = 1

CHUNK = 64
Q_BLOCK = 128
MEM_LEN = 256
MIX_WIDTH = D_MODEL
FOX_WIDTH = MIX_WIDTH // 2
FOX_HEAD_DIM = 64
FOX_HEADS = FOX_WIDTH // FOX_HEAD_DIM
GLA_WIDTH = MIX_WIDTH - FOX_WIDTH
GLA_HEADS = 4
GLA_VALUE_DIM = GLA_WIDTH // GLA_HEADS
GLA_KEY_DIM = GLA_VALUE_DIM // 2
GLA_KEY_WIDTH = GLA_HEADS * GLA_KEY_DIM
GLA_GATE_RANK = 16
GLA_TAU = 16.0
XATTN_HEADS = 4
XATTN_HEAD_DIM = D_MODEL // XATTN_HEADS
D_FF = 4 * D_MODEL
EPS = 1e-6
IN_SIZES = (FOX_WIDTH, FOX_WIDTH, FOX_WIDTH, FOX_HEADS,
            GLA_KEY_WIDTH, GLA_KEY_WIDTH, GLA_WIDTH, GLA_GATE_RANK, GLA_WIDTH)
IN_WIDTH = sum(IN_SIZES)

kernel_name = "hybrid_fox_gla_memxattn_block"


def _split_points():
    return [int(v) for v in np.cumsum(np.array(IN_SIZES))[:-1]]


def rms_norm(x, g):
    xf = x.astype(jnp.float32)
    y = xf * lax.rsqrt(jnp.mean(xf * xf, axis=-1, keepdims=True) + EPS)
    return (y * g.astype(jnp.float32)).astype(x.dtype)


def fox_attention(q, k, v, log_f):
    B, S, H, D = q.shape
    scale = 1.0 / math.sqrt(D)
    c = jnp.transpose(jnp.cumsum(log_f, axis=1), (0, 2, 1))
    outs = []
    for i in range(S // Q_BLOCK):
        start, end = i * Q_BLOCK, (i + 1) * Q_BLOCK
        qb = q[:, start:end]
        kb = k[:, :end]
        vb = v[:, :end]
        s = jnp.einsum('bqhd,bkhd->bhqk', qb, kb).astype(jnp.float32) * scale
        bias = c[:, :, start:end, None] - c[:, :, None, :end]
        q_pos = start + jnp.arange(Q_BLOCK)
        k_pos = jnp.arange(end)
        mask = k_pos[None, :] <= q_pos[:, None]
        s = jnp.where(mask, s + bias, -jnp.inf)
        p = jax.nn.softmax(s, axis=-1)
        outs.append(jnp.einsum('bhqk,bkhd->bqhd', p.astype(vb.dtype), vb))
    return jnp.concatenate(outs, axis=1)


def gla_chunked(q, k, v, g_log):
    B, S, H, Dk = q.shape
    Dv = v.shape[-1]
    N = S // CHUNK

    def to_chunks(a):
        return jnp.transpose(a.astype(jnp.float32).reshape(B, N, CHUNK, H, a.shape[-1]), (0, 3, 1, 2, 4))

    qc = to_chunks(q) * (Dk ** -0.5)
    kc = to_chunks(k)
    vc = to_chunks(v)
    bc = jnp.cumsum(to_chunks(g_log), axis=3)
    q_dec = qc * jnp.exp(bc)
    k_dec = kc * jnp.exp(-bc)
    A = jnp.einsum('bhnck,bhnsk->bhncs', q_dec, k_dec)
    tril = jnp.tril(jnp.ones((CHUNK, CHUNK), dtype=bool))
    A = jnp.where(tril, A, 0.0)
    o_intra = jnp.einsum('bhncs,bhnsv->bhncv', A, vc)
    b_last = bc[:, :, :, -1:, :]
    dS = jnp.einsum('bhnck,bhncv->bhnkv', kc * jnp.exp(b_last - bc), vc)
    decay = jnp.exp(b_last[:, :, :, 0, :])

    def step(state, inp):
        d, ds = inp
        return d[..., None] * state + ds, state

    init = jnp.zeros((B, H, Dk, Dv), jnp.float32)
    _, s_prev = lax.scan(step, init, (jnp.moveaxis(decay, 2, 0), jnp.moveaxis(dS, 2, 0)))
    s_prev = jnp.moveaxis(s_prev, 0, 2)
    o_inter = jnp.einsum('bhnck,bhnkv->bhncv', q_dec, s_prev)
    o = o_intra + o_inter
    o = jnp.transpose(o, (0, 2, 3, 1, 4)).reshape(B, S, H, Dv)
    return o.astype(v.dtype)


def parallel_mixer(xn, w_in, fox_b_f, fox_q_norm_g, fox_k_norm_g,
                   gla_w_gate2, gla_b_gate, gla_out_norm_g, w_out):
    B, S, _ = xn.shape
    proj = xn @ w_in
    fq, fk, fv, ff, gq, gk, gv, glr, gr = jnp.split(proj, _split_points(), axis=-1)
    fq = rms_norm(fq.reshape(B, S, FOX_HEADS, FOX_HEAD_DIM), fox_q_norm_g)
    fk = rms_norm(fk.reshape(B, S, FOX_HEADS, FOX_HEAD_DIM), fox_k_norm_g)
    fv = fv.reshape(B, S, FOX_HEADS, FOX_HEAD_DIM)
    log_f = jax.nn.log_sigmoid((ff + fox_b_f).astype(jnp.float32))
    fox_out = fox_attention(fq, fk, fv, log_f).reshape(B, S, FOX_WIDTH)
    g_log = jax.nn.log_sigmoid((glr @ gla_w_gate2 + gla_b_gate).astype(jnp.float32)) / GLA_TAU
    g_log = g_log.reshape(B, S, GLA_HEADS, GLA_KEY_DIM)
    gla_o = gla_chunked(gq.reshape(B, S, GLA_HEADS, GLA_KEY_DIM),
                        gk.reshape(B, S, GLA_HEADS, GLA_KEY_DIM),
                        gv.reshape(B, S, GLA_HEADS, GLA_VALUE_DIM), g_log)
    gla_o = rms_norm(gla_o, gla_out_norm_g.reshape(GLA_HEADS, GLA_VALUE_DIM)).reshape(B, S, GLA_WIDTH)
    gla_out = gla_o * jax.nn.silu(gr)
    return jnp.concatenate([fox_out, gla_out], axis=-1) @ w_out


def memory_cross_attention(hn, memn, wq, wkv, q_norm_g, k_norm_g, wo):
    B, S, _ = hn.shape
    M = memn.shape[1]
    q = rms_norm((hn @ wq).reshape(B, S, XATTN_HEADS, XATTN_HEAD_DIM), q_norm_g)
    k, v = jnp.split(memn @ wkv, 2, axis=-1)
    k = rms_norm(k.reshape(B, M, XATTN_HEADS, XATTN_HEAD_DIM), k_norm_g)
    v = v.reshape(B, M, XATTN_HEADS, XATTN_HEAD_DIM)
    s = jnp.einsum('bshd,bmhd->bhsm', q, k).astype(jnp.float32) / math.sqrt(XATTN_HEAD_DIM)
    p = jax.nn.softmax(s, axis=-1)
    o = jnp.einsum('bhsm,bmhd->bshd', p.astype(v.dtype), v).reshape(B, S, D_MODEL)
    return o @ wo


def setup_inputs(seed: int = 0) -> dict:
    key = jax.random.key(seed)
    ks = jax.random.split(key, 24)
    f32 = jnp.float32

    def nrm(k, shape, scale):
        return jax.random.normal(k, shape, f32) * scale

    def gain(k, shape):
        return jnp.ones(shape, f32) + 0.02 * jax.random.normal(k, shape, f32)

    return {
        "x": nrm(ks[0], (BATCH, SEQ, D_MODEL), 1.0),
        "mem": nrm(ks[1], (BATCH, MEM_LEN, D_MODEL), 1.0),
        "norm_mix_g": gain(ks[2], (D_MODEL,)),
        "w_in": nrm(ks[3], (D_MODEL, IN_WIDTH), D_MODEL ** -0.5),
        "fox_b_f": 2.0 + 0.1 * jax.random.normal(ks[4], (FOX_HEADS,), f32),
        "fox_q_norm_g": gain(ks[5], (FOX_HEAD_DIM,)),
        "fox_k_norm_g": gain(ks[6], (FOX_HEAD_DIM,)),
        "gla_w_gate2": nrm(ks[7], (GLA_GATE_RANK, GLA_KEY_WIDTH), GLA_GATE_RANK ** -0.5),
        "gla_b_gate": nrm(ks[8], (GLA_KEY_WIDTH,), 0.02),
        "gla_out_norm_g": gain(ks[9], (GLA_WIDTH,)),
        "w_out": nrm(ks[10], (MIX_WIDTH, D_MODEL), MIX_WIDTH ** -0.5),
        "norm_xattn_g": gain(ks[11], (D_MODEL,)),
        "norm_mem_g": gain(ks[12], (D_MODEL,)),
        "xattn_wq": nrm(ks[13], (D_MODEL, D_MODEL), D_MODEL ** -0.5),
        "xattn_wkv": nrm(ks[14], (D_MODEL, 2 * D_MODEL), D_MODEL ** -0.5),
        "xattn_q_norm_g": gain(ks[15], (XATTN_HEAD_DIM,)),
        "xattn_k_norm_g": gain(ks[16], (XATTN_HEAD_DIM,)),
        "xattn_wo": nrm(ks[17], (D_MODEL, D_MODEL), D_MODEL ** -0.5),
        "norm_mlp_g": gain(ks[18], (D_MODEL,)),
        "mlp_w1": nrm(ks[19], (D_MODEL, D_FF), D_MODEL ** -0.5),
        "mlp_w2": nrm(ks[20], (D_FF, D_MODEL), D_FF ** -0.5),
    }


def reference(x, mem, norm_mix_g, w_in, fox_b_f, fox_q_norm_g, fox_k_norm_g,
              gla_w_gate2, gla_b_gate, gla_out_norm_g, w_out,
              norm_xattn_g, norm_mem_g, xattn_wq, xattn_wkv, xattn_q_norm_g,
              xattn_k_norm_g, xattn_wo, norm_mlp_g, mlp_w1, mlp_w2):
    h = x
    for _ in range(DEPTH):
        h = h + parallel_mixer(rms_norm(h, norm_mix_g), w_in, fox_b_f, fox_q_norm_g,
                               fox_k_norm_g, gla_w_gate2, gla_b_gate, gla_out_norm_g, w_out)
        h = h + memory_cross_attention(rms_norm(h, norm_xattn_g), rms_norm(mem, norm_mem_g),
                                       xattn_wq, xattn_wkv, xattn_q_norm_g, xattn_k_norm_g, xattn_wo)
        u = jax.nn.relu(rms_norm(h, norm_mlp_g) @ mlp_w1)
        h = h + (u * u) @ mlp_w2
    return h
```

```cpp
#define PROBE_ID 0
#include <hip/hip_runtime.h>
#include <hip/hip_cooperative_groups.h>
#include <cstdio>
#include <cstdint>
namespace cg = cooperative_groups;

#define LAS __attribute__((address_space(3)))
#define DI __device__ __forceinline__
typedef unsigned short bf16_t;
typedef short bf16x8 __attribute__((ext_vector_type(8)));
typedef short s16x4 __attribute__((ext_vector_type(4)));
typedef float f32x4 __attribute__((ext_vector_type(4)));
typedef float f32x2 __attribute__((ext_vector_type(2)));
typedef float f32x16 __attribute__((ext_vector_type(16)));
typedef unsigned u32x4 __attribute__((ext_vector_type(4)));
typedef unsigned u32x2 __attribute__((ext_vector_type(2)));
typedef __bf16 bf16x2_t __attribute__((ext_vector_type(2)));
typedef short v4i16_t __attribute__((ext_vector_type(4)));

DI unsigned pk2(float lo, float hi) { f32x2 v = {lo, hi}; bf16x2_t b = __builtin_convertvector(v, bf16x2_t); return __builtin_bit_cast(unsigned, b); }
DI float bf2f(bf16_t u) { return __uint_as_float(((unsigned)u) << 16); }
DI float bflo(unsigned w) { return __uint_as_float(w << 16); }
DI float bfhi(unsigned w) { return __uint_as_float(w & 0xffff0000u); }
DI bf16_t f2bf(float f) { return (bf16_t)(pk2(f, 0.f) & 0xffffu); }
DI int get_tid() { int t = threadIdx.x; asm volatile("" : "+v"(t)); return t; }
DI int crow(int r, int hi) { return (r & 3) + 8 * (r >> 2) + 4 * hi; }
#define BAR_LDS() do { asm volatile("s_waitcnt lgkmcnt(0)" ::: "memory"); __builtin_amdgcn_s_barrier(); asm volatile("" ::: "memory"); } while (0)

constexpr int DM = 1024, NBATCH = 4, SEQ = 8192, MTOK = NBATCH * SEQ, NPROJ = 3328, FF = 4096, MEMLEN = 256;
constexpr int C_FQ = 0, C_FK = 512, C_FV = 1024, C_GQ = 1536, C_GK = 1792, C_GV = 2048, C_GR = 2560;
constexpr float EPS = 1e-6f, LOG2E = 1.4426950408889634f;
constexpr int RED_OFF = 131072;
constexpr int MISC_OFF = 131072 + 8192;
constexpr int LDS_BYTES = 131072 + 8192 + 1024;

namespace pg8 {
constexpr int BM = 256, BK = 64, HALF = 128, HTB = HALF * BK * 2, STAGE_BYTES = 8 * HTB, NXCD = 8, WGM = 4;
__host__ __device__ __forceinline__ int lds_byte(int r, int c) { const int st = (r >> 4) * 2 + (c >> 5), rr = r & 15, cc = c & 31, ob = rr * 64 + cc * 2; return st * 1024 + (ob ^ (((ob >> 9) & 1) << 5)); }
__host__ __device__ __forceinline__ void stage_rc(int b, int& R, int& C) { const int st = b / 1024, sb = b % 1024, swz = sb ^ (((sb >> 9) & 1) << 5); R = (st >> 1) * 16 + swz / 64; C = (st & 1) * 32 + (swz % 64) / 2; }
__host__ __device__ __forceinline__ int perm32(int rho) { const int n = rho >> 4, i = rho & 15; return 8 * (i >> 2) + 4 * n + (i & 3); }

struct Unit { int pm, pn; };
struct Gemm { const bf16_t* A; const bf16_t* Bt; };
template <int K_, int LDA_, int LDB_, long APN_, long BPN_, long BBATCH_, int BSHIFT_, int PNBITS_ = 30, long BPNHI_ = 0> struct Geo { static constexpr int K = K_, LDA = LDA_, LDB = LDB_, BSHIFT = BSHIFT_, PNBITS = PNBITS_; static constexpr long APN = APN_, BPN = BPN_, BBATCH = BBATCH_, BPNHI = BPNHI_; };
template <int K_> using GeoPlain = Geo<K_, K_, K_, 0, 256L * K_, 0, 0>;

struct StaticOrder {
    int nM, nN, nwg, G, c;
    __host__ __device__ void init(int M, int N, int G_, int c_) { nM = M / BM; nN = N / BM; nwg = nM * nN; G = G_; c = c_; }
    __host__ __device__ bool next(int i, Unit& u) const {
        const long L = (long)i * G + c; if (L >= nwg) return false;
        int wgid = (int)L; { const int q = nwg / NXCD, r = nwg % NXCD, xcd = wgid % NXCD, off = wgid / NXCD; wgid = (xcd < r ? xcd * (q + 1) : r * (q + 1) + (xcd - r) * q) + off; }
        const int nig = WGM * nN, gid = wgid / nig, fm = gid * WGM, gsz = (nM - fm) < WGM ? (nM - fm) : WGM;
        u.pm = fm + ((wgid % nig) % gsz); u.pn = (wgid % nig) / gsz; return true;
    }
};

typedef f32x4 Acc[2][2][4][2];

template <bool ISMAX> DI void tile_row_reduce(float (&p)[2][4], LAS float* red, int wr, int wc, int fr, int fq) {
#pragma unroll
    for (int ai = 0; ai < 2; ++ai)
#pragma unroll
        for (int m = 0; m < 4; ++m) { float v = p[ai][m]; const float a = __shfl_xor(v, 16); v = ISMAX ? fmaxf(v, a) : v + a; const float b = __shfl_xor(v, 32); v = ISMAX ? fmaxf(v, b) : v + b;
            if (fq == 0) red[(ai * 128 + wr * 64 + m * 16 + fr) * 4 + wc] = v; }
    BAR_LDS();
#pragma unroll
    for (int ai = 0; ai < 2; ++ai)
#pragma unroll
        for (int m = 0; m < 4; ++m) { const f32x4 q = *(const LAS f32x4*)(red + (ai * 128 + wr * 64 + m * 16 + fr) * 4);
            p[ai][m] = ISMAX ? fmaxf(fmaxf(q.x, q.y), fmaxf(q.z, q.w)) : (q.x + q.y) + (q.z + q.w); }
}

template <bool BASE_BF16, bool OUT_F32, bool OUT_BF16> struct EpiRes {
    static constexpr bool PERM = true;
    const void* base; float* out; bf16_t* hb; float* sumsq;
    DI void operator()(Acc& acc, const Unit& u, int wr, int wc, int fr, int fq, LAS unsigned char* lds) const {
        const int col0 = u.pn * BM + wc * 32 + 8 * fq;
        float part[2][4];
#pragma unroll
        for (int ai = 0; ai < 2; ++ai)
#pragma unroll
            for (int m = 0; m < 4; ++m) { const int row = u.pm * BM + ai * HALF + wr * 64 + m * 16 + fr; const size_t off = (size_t)row * DM + col0; float ss = 0.f;
#pragma unroll
                for (int bj = 0; bj < 2; ++bj) { const size_t o = off + bj * HALF;
                    f32x4 b0, b1;
                    if (BASE_BF16) { const u32x4 w = *(const u32x4*)((const bf16_t*)base + o); b0 = (f32x4){bflo(w.x), bfhi(w.x), bflo(w.y), bfhi(w.y)}; b1 = (f32x4){bflo(w.z), bfhi(w.z), bflo(w.w), bfhi(w.w)}; }
                    else { b0 = *(const f32x4*)((const float*)base + o); b1 = *(const f32x4*)((const float*)base + o + 4); }
                    const f32x4 v0 = b0 + acc[ai][bj][m][0], v1 = b1 + acc[ai][bj][m][1];
                    if (OUT_F32) { __builtin_nontemporal_store(v0, (f32x4*)(out + o)); __builtin_nontemporal_store(v1, (f32x4*)(out + o + 4)); }
                    if (OUT_BF16) { u32x4 w; w.x = pk2(v0.x, v0.y); w.y = pk2(v0.z, v0.w); w.z = pk2(v1.x, v1.y); w.w = pk2(v1.z, v1.w); *(u32x4*)(hb + o) = w;
                        ss += ((v0.x * v0.x + v0.y * v0.y) + (v0.z * v0.z + v0.w * v0.w)) + ((v1.x * v1.x + v1.y * v1.y) + (v1.z * v1.z + v1.w * v1.w)); } }
                part[ai][m] = ss; }
        if (OUT_BF16) {
            tile_row_reduce<false>(part, (LAS float*)(lds + RED_OFF), wr, wc, fr, fq);
            if (wc == 0 && fq == 0) {
#pragma unroll
                for (int ai = 0; ai < 2; ++ai)
#pragma unroll
                    for (int m = 0; m < 4; ++m) sumsq[(size_t)(u.pm * BM + ai * HALF + wr * 64 + m * 16 + fr) * 4 + u.pn] = part[ai][m]; }
        }
    }
};
template <int ldc, int act, bool HAS_RS, int aux_pn> struct EpiBf {
    static constexpr bool PERM = true;
    bf16_t* O; const float* sumsq; float* aux;
    DI void operator()(Acc& acc, const Unit& u, int wr, int wc, int fr, int fq, LAS unsigned char*) const {
        if (aux_pn >= 0 && u.pn == aux_pn) {
            if (wc == 0) {
#pragma unroll
                for (int ai = 0; ai < 2; ++ai)
#pragma unroll
                    for (int m = 0; m < 4; ++m) { const int row = u.pm * BM + ai * HALF + wr * 64 + m * 16 + fr;
#pragma unroll
                        for (int n = 0; n < 2; ++n) *(f32x4*)(aux + (size_t)row * 32 + 8 * fq + 4 * n) = acc[ai][0][m][n]; } }
            return; }
        const int col0 = u.pn * BM + wc * 32 + 8 * fq;
#pragma unroll
        for (int ai = 0; ai < 2; ++ai)
#pragma unroll
            for (int m = 0; m < 4; ++m) { const int row = u.pm * BM + ai * HALF + wr * 64 + m * 16 + fr; bf16_t* rowp = O + (size_t)row * ldc + col0;
                float rs = 1.0f; if (HAS_RS) { const f32x4 q4 = *(const f32x4*)(sumsq + (size_t)row * 4); rs = rsqrtf(((q4.x + q4.y) + (q4.z + q4.w)) * (1.0f / DM) + EPS); }
#pragma unroll
                for (int bj = 0; bj < 2; ++bj) { f32x4 v0 = acc[ai][bj][m][0] * rs, v1 = acc[ai][bj][m][1] * rs;
                    if (act) { v0 = __builtin_elementwise_max(v0, (f32x4){0.f, 0.f, 0.f, 0.f}); v1 = __builtin_elementwise_max(v1, (f32x4){0.f, 0.f, 0.f, 0.f}); v0 = v0 * v0; v1 = v1 * v1; }
                    u32x4 w; w.x = pk2(v0.x, v0.y); w.y = pk2(v0.z, v0.w); w.z = pk2(v1.x, v1.y); w.w = pk2(v1.z, v1.w);
                    if (act) __builtin_nontemporal_store(w, (u32x4*)(rowp + bj * HALF)); else *(u32x4*)(rowp + bj * HALF) = w; } }
    }
};
struct EpiProj {
    static constexpr bool PERM = true;
    bf16_t* O; float* aux; const float* gq; const float* gk;
    DI void operator()(Acc& acc, const Unit& u, int wr, int wc, int fr, int fq, LAS unsigned char* lds) const {
        if (u.pn == 12) {
            if (wc == 0) {
#pragma unroll
                for (int ai = 0; ai < 2; ++ai)
#pragma unroll
                    for (int m = 0; m < 4; ++m) { const int row = u.pm * BM + ai * HALF + wr * 64 + m * 16 + fr;
#pragma unroll
                        for (int n = 0; n < 2; ++n) *(f32x4*)(aux + (size_t)row * 32 + 8 * fq + 4 * n) = acc[ai][0][m][n]; } }
            return; }
        const int col0 = u.pn * BM + wc * 32 + 8 * fq;
        if (u.pn < 4) {
            LAS float* red = (LAS float*)(lds + RED_OFF);
#pragma unroll
            for (int ai = 0; ai < 2; ++ai)
#pragma unroll
                for (int m = 0; m < 4; ++m)
#pragma unroll
                    for (int bj = 0; bj < 2; ++bj) { const f32x4 v0 = acc[ai][bj][m][0], v1 = acc[ai][bj][m][1];
                        float ss = ((v0.x * v0.x + v0.y * v0.y) + (v0.z * v0.z + v0.w * v0.w)) + ((v1.x * v1.x + v1.y * v1.y) + (v1.z * v1.z + v1.w * v1.w));
                        ss += __shfl_xor(ss, 16); ss += __shfl_xor(ss, 32);
                        if (fq == 0) red[(ai * 128 + wr * 64 + m * 16 + fr) * 8 + bj * 4 + wc] = ss; }
            BAR_LDS();
            const bool isk = u.pn >= 2; const float* g = (isk ? gk : gq) + 32 * (wc & 1) + 8 * fq; const float sc = isk ? 1.0f : 0.125f * LOG2E;
            const f32x4 g0 = *(const f32x4*)g, g1 = *(const f32x4*)(g + 4);
#pragma unroll
            for (int ai = 0; ai < 2; ++ai)
#pragma unroll
                for (int m = 0; m < 4; ++m) { const int rl = ai * HALF + wr * 64 + m * 16 + fr; bf16_t* rowp = O + (size_t)(u.pm * BM + rl) * NPROJ + col0;
#pragma unroll
                    for (int bj = 0; bj < 2; ++bj) { const f32x2 pr = *(const LAS f32x2*)(red + rl * 8 + bj * 4 + (wc & 2)); const float tot = pr.x + pr.y; const float rs = rsqrtf(tot * (1.0f / 64.0f) + EPS) * sc;
                        const f32x4 v0 = acc[ai][bj][m][0] * rs * g0, v1 = acc[ai][bj][m][1] * rs * g1;
                        u32x4 w; w.x = pk2(v0.x, v0.y); w.y = pk2(v0.z, v0.w); w.z = pk2(v1.x, v1.y); w.w = pk2(v1.z, v1.w); *(u32x4*)(rowp + bj * HALF) = w; } }
            return; }
#pragma unroll
        for (int ai = 0; ai < 2; ++ai)
#pragma unroll
            for (int m = 0; m < 4; ++m) { const int row = u.pm * BM + ai * HALF + wr * 64 + m * 16 + fr; bf16_t* rowp = O + (size_t)row * NPROJ + col0;
#pragma unroll
                for (int bj = 0; bj < 2; ++bj) { const f32x4 v0 = acc[ai][bj][m][0], v1 = acc[ai][bj][m][1];
                    u32x4 w; w.x = pk2(v0.x, v0.y); w.y = pk2(v0.z, v0.w); w.z = pk2(v1.x, v1.y); w.w = pk2(v1.z, v1.w); *(u32x4*)(rowp + bj * HALF) = w; } }
    }
};
struct EpiNorm {
    static constexpr bool PERM = true;
    bf16_t* O; const float* sumsq; const float* gain; float scale; bf16_t* vt;
    DI void operator()(Acc& acc, const Unit& u, int wr, int wc, int fr, int fq, LAS unsigned char* lds) const {
        if (vt && u.pn >= 4) {
#pragma unroll
            for (int ai = 0; ai < 2; ++ai)
#pragma unroll
                for (int m = 0; m < 4; ++m) { const int row = u.pm * BM + ai * HALF + wr * 64 + m * 16 + fr; bf16_t* rowp = vt + (size_t)row * DM + (u.pn - 4) * BM + wc * 32 + 8 * fq;
#pragma unroll
                    for (int bj = 0; bj < 2; ++bj) { const f32x4 v0 = acc[ai][bj][m][0], v1 = acc[ai][bj][m][1];
                        u32x4 w; w.x = pk2(v0.x, v0.y); w.y = pk2(v0.z, v0.w); w.z = pk2(v1.x, v1.y); w.w = pk2(v1.z, v1.w); *(u32x4*)(rowp + bj * HALF) = w; } }
            return; }
        LAS float* red = (LAS float*)(lds + RED_OFF);
        float part[2][4];
#pragma unroll
        for (int ai = 0; ai < 2; ++ai)
#pragma unroll
            for (int m = 0; m < 4; ++m) { const int row = u.pm * BM + ai * HALF + wr * 64 + m * 16 + fr;
                float rs = 1.0f; if (sumsq) { const f32x4 q4 = *(const f32x4*)(sumsq + (size_t)row * 4); rs = rsqrtf(((q4.x + q4.y) + (q4.z + q4.w)) * (1.0f / DM) + EPS); } float ss = 0.f;
#pragma unroll
                for (int bj = 0; bj < 2; ++bj)
#pragma unroll
                    for (int n = 0; n < 2; ++n) { const f32x4 v = acc[ai][bj][m][n] * rs; acc[ai][bj][m][n] = v; ss += (v.x * v.x + v.y * v.y) + (v.z * v.z + v.w * v.w); }
                part[ai][m] = ss; }
        tile_row_reduce<false>(part, red, wr, wc, fr, fq);
        const int cin = wc * 32 + 8 * fq;
#pragma unroll
        for (int ai = 0; ai < 2; ++ai)
#pragma unroll
            for (int m = 0; m < 4; ++m) { const int row = u.pm * BM + ai * HALF + wr * 64 + m * 16 + fr; const float rn = rsqrtf(part[ai][m] * (1.0f / 256.0f) + EPS) * scale;
                bf16_t* rowp = O + (size_t)row * DM + u.pn * BM + cin;
#pragma unroll
                for (int bj = 0; bj < 2; ++bj) { const f32x4 g0 = *(const f32x4*)(gain + bj * HALF + cin), g1 = *(const f32x4*)(gain + bj * HALF + cin + 4);
                    const f32x4 v0 = acc[ai][bj][m][0] * rn * g0, v1 = acc[ai][bj][m][1] * rn * g1;
                    u32x4 w; w.x = pk2(v0.x, v0.y); w.y = pk2(v0.z, v0.w); w.z = pk2(v1.x, v1.y); w.w = pk2(v1.z, v1.w); *(u32x4*)(rowp + bj * HALF) = w; } }
    }
};
struct EpiSoftmax {
    static constexpr bool PERM = true;
    bf16_t* O;
    DI void operator()(Acc& acc, const Unit& u, int wr, int wc, int fr, int fq, LAS unsigned char* lds) const {
        LAS float* red = (LAS float*)(lds + RED_OFF);
        float part[2][4];
#pragma unroll
        for (int ai = 0; ai < 2; ++ai)
#pragma unroll
            for (int m = 0; m < 4; ++m) { float mx = -3.0e38f;
#pragma unroll
                for (int bj = 0; bj < 2; ++bj)
#pragma unroll
                    for (int n = 0; n < 2; ++n) { const f32x4 v = acc[ai][bj][m][n]; mx = fmaxf(mx, fmaxf(fmaxf(v.x, v.y), fmaxf(v.z, v.w))); }
                part[ai][m] = mx; }
        tile_row_reduce<true>(part, red, wr, wc, fr, fq);
        float part2[2][4];
#pragma unroll
        for (int ai = 0; ai < 2; ++ai)
#pragma unroll
            for (int m = 0; m < 4; ++m) { const float mx = part[ai][m] * LOG2E; float s = 0.f;
#pragma unroll
                for (int bj = 0; bj < 2; ++bj)
#pragma unroll
                    for (int n = 0; n < 2; ++n) { f32x4 v = acc[ai][bj][m][n];
#pragma unroll
                        for (int e = 0; e < 4; ++e) { v[e] = __builtin_amdgcn_exp2f(v[e] * LOG2E - mx); s += v[e]; }
                        acc[ai][bj][m][n] = v; }
                part2[ai][m] = s; }
        tile_row_reduce<false>(part2, red + 1024, wr, wc, fr, fq);
        const int cin = wc * 32 + 8 * fq;
#pragma unroll
        for (int ai = 0; ai < 2; ++ai)
#pragma unroll
            for (int m = 0; m < 4; ++m) { const int row = u.pm * BM + ai * HALF + wr * 64 + m * 16 + fr; const float inv = 1.0f / part2[ai][m];
                bf16_t* rowp = O + (size_t)row * DM + u.pn * BM + cin;
#pragma unroll
                for (int bj = 0; bj < 2; ++bj) { const f32x4 v0 = acc[ai][bj][m][0] * inv, v1 = acc[ai][bj][m][1] * inv;
                    u32x4 w; w.x = pk2(v0.x, v0.y); w.y = pk2(v0.z, v0.w); w.z = pk2(v1.x, v1.y); w.w = pk2(v1.z, v1.w); *(u32x4*)(rowp + bj * HALF) = w; } }
    }
};

template <class GEO, class Epi>
__device__ __forceinline__ void gemm_phase(LAS unsigned char* lds, const Gemm g, const StaticOrder& S, const Epi& E) {
    const int tid = get_tid(), wid = __builtin_amdgcn_readfirstlane(tid >> 6), lane = tid & 63, wr = wid >> 2, wc = wid & 3, fr = lane & 15, fq = lane >> 4;
    constexpr int K = GEO::K, nt = K / BK;
    unsigned voffA[2], voffB[2];
#pragma unroll
    for (int i = 0; i < 2; ++i) { int R, C; stage_rc(tid * 16 + i * 8192, R, C); const int Rb = Epi::PERM ? ((R & ~31) + perm32(R & 31)) : R;
        voffA[i] = (unsigned)(R * GEO::LDA + C) * 2u; voffB[i] = (unsigned)(Rb * GEO::LDB + C) * 2u; }
    const size_t kstep = (size_t)(BK * 2);
    constexpr size_t hstepA = (size_t)HALF * GEO::LDA * 2, hstepB = (size_t)HALF * GEO::LDB * 2;
    const unsigned ldsw = (unsigned)wid * 1024u;
    const int aoff = lds_byte(wr * 64 + fr, fq * 8), boff = lds_byte(wc * 32 + fr, fq * 8);
#define PG8_SA(b, h) (((b) * 2 + (h)) * HTB)
#define PG8_SB(b, h) ((4 + (b) * 2 + (h)) * HTB)
#define PG8_STAGE(bufoff, gbase, voff) do { _Pragma("unroll") for (int _i = 0; _i < 2; ++_i) \
        __builtin_amdgcn_global_load_lds((const unsigned*)((const char*)(gbase) + (voff)[_i]), (LAS unsigned*)(lds + (bufoff) + ldsw + _i * 8192), 16, 0, 0); } while (0)
#define PG8_LDA(dst, b, h) do { _Pragma("unroll") for (int m = 0; m < 4; ++m) _Pragma("unroll") for (int k = 0; k < 2; ++k) dst[m][k] = *(const LAS bf16x8*)(lds + PG8_SA(b, h) + aoff + m * 2048 + k * 1024); } while (0)
#define PG8_LDB(dst, b, h) do { _Pragma("unroll") for (int n = 0; n < 2; ++n) _Pragma("unroll") for (int k = 0; k < 2; ++k) dst[n][k] = *(const LAS bf16x8*)(lds + PG8_SB(b, h) + boff + n * 2048 + k * 1024); } while (0)
#define PG8_MMA(ai, bj, At, Bt) do { __builtin_amdgcn_s_setprio(1); _Pragma("unroll") for (int m = 0; m < 4; ++m) _Pragma("unroll") for (int n = 0; n < 2; ++n) _Pragma("unroll") for (int k = 0; k < 2; ++k) \
        acc[ai][bj][m][n] = __builtin_amdgcn_mfma_f32_16x16x32_bf16(Bt[n][k], At[m][k], acc[ai][bj][m][n], 0, 0, 0); __builtin_amdgcn_s_setprio(0); } while (0)
#define PG8_WAIT_V(n) asm volatile("s_waitcnt vmcnt(" #n ")" ::: "memory")
#define PG8_WAIT_L(n) asm volatile("s_waitcnt lgkmcnt(" #n ")" ::: "memory")
#define PG8_BAR __builtin_amdgcn_s_barrier()
#define PG8_SCHED __builtin_amdgcn_sched_barrier(0)
#define PG8_APTR(u) ((const char*)g.A + ((size_t)(u).pm * BM * GEO::LDA + (size_t)((u).pn & ((1 << GEO::PNBITS) - 1)) * GEO::APN) * 2)
#define PG8_BPTR(u) ((const char*)g.Bt + ((size_t)((u).pn & ((1 << GEO::PNBITS) - 1)) * GEO::BPN + (size_t)((u).pn >> GEO::PNBITS) * GEO::BPNHI + (size_t)((u).pm >> GEO::BSHIFT) * GEO::BBATCH) * 2)
    Unit cur, nxt; int ui = 0;
    if (!S.next(0, cur)) return;
    Acc acc;
#pragma unroll
    for (int a = 0; a < 2; ++a)
#pragma unroll
        for (int b = 0; b < 2; ++b)
#pragma unroll
            for (int m = 0; m < 4; ++m)
#pragma unroll
                for (int n = 0; n < 2; ++n) acc[a][b][m][n] = (f32x4){0.f, 0.f, 0.f, 0.f};
    bf16x8 At[4][2], B0[2][2], B1[2][2];
    const char* cA = PG8_APTR(cur); const char* cB = PG8_BPTR(cur);
    PG8_STAGE(PG8_SB(0, 0), cB, voffB); PG8_STAGE(PG8_SB(0, 1), cB + hstepB, voffB); PG8_STAGE(PG8_SA(0, 0), cA, voffA); PG8_STAGE(PG8_SA(0, 1), cA + hstepA, voffA);
    if (wr == 1) PG8_BAR;
    PG8_WAIT_V(2); PG8_BAR;
    PG8_STAGE(PG8_SB(1, 0), cB + kstep, voffB); PG8_STAGE(PG8_SA(1, 0), cA + kstep, voffA); PG8_STAGE(PG8_SB(1, 1), cB + hstepB + kstep, voffB);
    PG8_WAIT_V(6); PG8_BAR;
    for (;;) {
        const bool has_next = S.next(ui + 1, nxt);
        const char* nA = has_next ? PG8_APTR(nxt) : cA; const char* nB = has_next ? PG8_BPTR(nxt) : cB;
#pragma nounroll
        for (int t = 0; t < nt; t += 2) {
            const bool last = (t == nt - 2);
            const char* a1 = cA + (size_t)(t + 1) * kstep;
            const char* a2 = last ? nA : cA + (size_t)(t + 2) * kstep; const char* b2 = last ? nB : cB + (size_t)(t + 2) * kstep;
            const char* a3 = a2 + kstep; const char* b3 = b2 + kstep;
            PG8_LDB(B0, 0, 0); PG8_LDB(B1, 0, 1); PG8_SCHED; PG8_LDA(At, 0, 0); PG8_STAGE(PG8_SA(1, 1), a1 + hstepA, voffA);
            PG8_WAIT_V(8); PG8_WAIT_L(0); PG8_BAR; PG8_MMA(0, 0, At, B0); PG8_MMA(0, 1, At, B1); PG8_BAR; PG8_SCHED;
            PG8_LDA(At, 0, 1); PG8_STAGE(PG8_SB(0, 0), b2, voffB); PG8_STAGE(PG8_SB(0, 1), b2 + hstepB, voffB); PG8_STAGE(PG8_SA(0, 0), a2, voffA);
            PG8_WAIT_V(8); PG8_WAIT_L(0); PG8_BAR; PG8_MMA(1, 0, At, B0); PG8_MMA(1, 1, At, B1); PG8_BAR; PG8_SCHED;
            PG8_LDB(B0, 1, 0); PG8_LDB(B1, 1, 1); PG8_SCHED; PG8_LDA(At, 1, 0); PG8_STAGE(PG8_SA(0, 1), a2 + hstepA, voffA);
            PG8_WAIT_V(8); PG8_WAIT_L(0); PG8_BAR; PG8_MMA(0, 0, At, B0); PG8_MMA(0, 1, At, B1); PG8_BAR; PG8_SCHED;
            PG8_LDA(At, 1, 1); PG8_STAGE(PG8_SB(1, 0), b3, voffB); PG8_STAGE(PG8_SB(1, 1), b3 + hstepB, voffB); PG8_STAGE(PG8_SA(1, 0), a3, voffA);
            PG8_WAIT_V(8); PG8_WAIT_L(0); PG8_BAR; PG8_MMA(1, 0, At, B0); PG8_MMA(1, 1, At, B1); PG8_BAR; PG8_SCHED;
        }
        if (wr == 0) PG8_BAR;
        E(acc, cur, wr, wc, fr, fq, lds);
        if (!has_next) break;
#pragma unroll
        for (int a = 0; a < 2; ++a)
#pragma unroll
            for (int b = 0; b < 2; ++b)
#pragma unroll
                for (int m = 0; m < 4; ++m)
#pragma unroll
                    for (int n = 0; n < 2; ++n) acc[a][b][m][n] = (f32x4){0.f, 0.f, 0.f, 0.f};
        cur = nxt; cA = nA; cB = nB; ++ui;
        if (wr == 1) PG8_BAR;
    }
    PG8_WAIT_V(0);
    PG8_BAR;
#undef PG8_SA
#undef PG8_SB
#undef PG8_STAGE
#undef PG8_LDA
#undef PG8_LDB
#undef PG8_MMA
#undef PG8_WAIT_V
#undef PG8_WAIT_L
#undef PG8_BAR
#undef PG8_SCHED
#undef PG8_APTR
#undef PG8_BPTR
}
}

constexpr size_t MiB = 1u << 20;
constexpr size_t WS_SUMSQ1 = 0, WS_SUMSQ2 = 1024 * 1024, WS_BAR = 512 * 1024;
constexpr size_t WS_WIN = 2 * MiB, WS_WOUT = 9 * MiB, WS_WQ = 11 * MiB, WS_WKV = 13 * MiB, WS_WO = 17 * MiB, WS_W1 = 19 * MiB, WS_W2 = 27 * MiB;
constexpr size_t WS_MEMN = 36 * MiB, WS_KN = 38 * MiB, WS_VT = 40 * MiB, WS_AUX = 42 * MiB;
constexpr size_t WS_CLOC = 46 * MiB, WS_CTOT = 47 * MiB, WS_DECAY = 47 * MiB + 65536;
constexpr size_t WS_XN = 48 * MiB, WS_DST = 48 * MiB, WS_U = 48 * MiB;
constexpr size_t WS_PROJ = 112 * MiB, WS_QN = 112 * MiB, WS_P = 176 * MiB;
constexpr size_t WS_VWT = 480 * MiB;
constexpr size_t WS_SPT = 320 * MiB, WS_MIX = 352 * MiB, WS_HB = 416 * MiB, WS_END = 488 * MiB;

struct Params {
    const float *x, *mem, *norm_mix_g, *w_in, *fox_b_f, *fox_q_g, *fox_k_g, *gla_w2, *gla_bg, *gla_og, *w_out, *norm_x_g, *norm_mem_g, *wq, *wkv, *xq_g, *xk_g, *wo, *norm_mlp_g, *w1, *w2;
    float* out; unsigned char* ws;
    long never;
};

DI float wave_sum(float v) {
#pragma unroll
    for (int o = 1; o < 64; o <<= 1) v += __shfl_xor(v, o);
    return v;
}
DI float logsig(float z) { return fminf(z, 0.f) - log1pf(expf(-fabsf(z))); }
DI float logsig_fast(float z) { return fminf(z, 0.f) - __logf(1.0f + __expf(-fabsf(z))); }

DI void p0_transpose_item(const float* W, int ldw, int src0, int K, bf16_t* WT, int dst0, const float* gain, LAS float* scr, int kb, int nb, int lane) {
    const int k0 = 64 * kb, n0 = 32 * nb, kr = lane >> 3, c4 = lane & 7;
    f32x4 v[8];
#pragma unroll
    for (int i = 0; i < 8; ++i) v[i] = __builtin_nontemporal_load((const f32x4*)(W + (size_t)(k0 + kr + 8 * i) * ldw + src0 + n0 + 4 * c4));
#pragma unroll
    for (int i = 0; i < 8; ++i) { const float g = gain ? gain[k0 + kr + 8 * i] : 1.0f; LAS float* d = scr + (kr + 8 * i) * 33 + 4 * c4; d[0] = v[i].x * g; d[1] = v[i].y * g; d[2] = v[i].z * g; d[3] = v[i].w * g; }
    asm volatile("s_waitcnt lgkmcnt(0)" ::: "memory");
    const int c = lane & 7;
#pragma unroll
    for (int j = 0; j < 4; ++j) { const int n = (lane >> 3) + 8 * j; const LAS float* s = scr + (8 * c) * 33 + n;
        u32x4 o; o.x = pk2(s[0 * 33], s[1 * 33]); o.y = pk2(s[2 * 33], s[3 * 33]); o.z = pk2(s[4 * 33], s[5 * 33]); o.w = pk2(s[6 * 33], s[7 * 33]);
        *(u32x4*)(WT + (size_t)(dst0 + n0 + n) * K + k0 + 8 * c) = o; }
    asm volatile("s_waitcnt lgkmcnt(0)" ::: "memory");
}
template <int NR> DI void rms_rows_load(f32x4 (&v)[NR][4], const float* xrow, int lane) {
#pragma unroll
    for (int r = 0; r < NR; ++r) { const f32x4* xr = (const f32x4*)(xrow + (size_t)r * DM) + lane;
#pragma unroll
        for (int j = 0; j < 4; ++j) v[r][j] = __builtin_nontemporal_load(xr + 64 * j); }
}
template <int NR> DI void rms_rows_store(const f32x4 (&v)[NR][4], const float* g, bf16_t* orow, int lane) {
    float s[NR];
#pragma unroll
    for (int r = 0; r < NR; ++r) { float a = 0.f;
#pragma unroll
        for (int j = 0; j < 4; ++j) a += (v[r][j].x * v[r][j].x + v[r][j].y * v[r][j].y) + (v[r][j].z * v[r][j].z + v[r][j].w * v[r][j].w);
        s[r] = a; }
#pragma unroll
    for (int o = 1; o < 64; o <<= 1)
#pragma unroll
        for (int r = 0; r < NR; ++r) s[r] += __shfl_xor(s[r], o);
    const f32x4* gr = (const f32x4*)g + lane;
#pragma unroll
    for (int j = 0; j < 4; ++j) { const f32x4 gg = gr[64 * j];
#pragma unroll
        for (int r = 0; r < NR; ++r) { const float rstd = rsqrtf(s[r] * (1.f / DM) + EPS); u32x2 w; w.x = pk2(v[r][j].x * rstd * gg.x, v[r][j].y * rstd * gg.y); w.y = pk2(v[r][j].z * rstd * gg.z, v[r][j].w * rstd * gg.w);
            ((u32x2*)(orow + (size_t)r * DM) + lane)[64 * j] = w; } }
}
DI void late_transposes(const Params& p, LAS unsigned char* lds, int gwv, int ngw) {
    const int tid = get_tid(), lane = tid & 63, wave = tid >> 6;
    unsigned char* ws = p.ws;
    LAS float* scr = (LAS float*)(lds + wave * 16384);
    constexpr int J3 = 16 * 32, J4 = 16 * 32, J6 = 16 * 32, J7 = 16 * 128, J8 = 64 * 32;
    for (int it = gwv; it < J3 + J4 + J6 + J7 + J8; it += ngw) {
        int r = it;
        if (r < J3) { p0_transpose_item(p.w_out, DM, 0, DM, (bf16_t*)(ws + WS_WOUT), 0, nullptr, scr, r / 32, r % 32, lane); continue; } r -= J3;
        if (r < J4) { p0_transpose_item(p.wq, DM, 0, DM, (bf16_t*)(ws + WS_WQ), 0, p.norm_x_g, scr, r / 32, r % 32, lane); continue; } r -= J4;
        if (r < J6) { p0_transpose_item(p.wo, DM, 0, DM, (bf16_t*)(ws + WS_WO), 0, nullptr, scr, r / 32, r % 32, lane); continue; } r -= J6;
        if (r < J7) { p0_transpose_item(p.w1, FF, 0, DM, (bf16_t*)(ws + WS_W1), 0, p.norm_mlp_g, scr, r / 128, r % 128, lane); continue; } r -= J7;
        p0_transpose_item(p.w2, DM, 0, FF, (bf16_t*)(ws + WS_W2), 0, nullptr, scr, r / 32, r % 32, lane);
    }
}
DI void p0_prologue(const Params& p, LAS unsigned char* lds, int G) {
    const int tid = get_tid(), lane = tid & 63, wave = tid >> 6;
    unsigned char* ws = p.ws;
    LAS float* scr = (LAS float*)(lds + wave * 16384);
    const int gw = blockIdx.x * 8 + wave, NGW = G * 8;
    constexpr int I0 = 16 * 48, I1 = 16 * 32, I2 = 16 * 16, I3 = 16 * 32, I4 = 16 * 32, I5 = 16 * 64, I6 = 16 * 32, I7 = 16 * 128, I8 = 64 * 32;
    constexpr int NITEMS = I0 + I1 + I2 + I3 + I4 + I5 + I6 + I7 + I8;
    const int wu = __builtin_amdgcn_readfirstlane(wave);
    for (int ph = 0; ph < 2; ++ph) {
    if (((ph ^ wu) & 1) == 1) {
    for (int r16 = 0; r16 < (PROBE_ID == 16 ? 2 : 1); ++r16) {
    for (int it = gw; it < I0 + I1 + I2 + I5; it += NGW) {
        int r = it;
        if (r < I0) { p0_transpose_item(p.w_in, 3096, 0, DM, (bf16_t*)(ws + WS_WIN), 0, nullptr, scr, r / 48, r % 48, lane); continue; } r -= I0;
        if (r < I1) { p0_transpose_item(p.w_in, 3096, 1544, DM, (bf16_t*)(ws + WS_WIN), 1536, nullptr, scr, r / 32, r % 32, lane); continue; } r -= I1;
        if (r < I2) { p0_transpose_item(p.w_in, 3096, 2584, DM, (bf16_t*)(ws + WS_WIN), 2560, nullptr, scr, r / 16, r % 16, lane); continue; } r -= I2;
        p0_transpose_item(p.wkv, 2 * DM, 0, DM, (bf16_t*)(ws + WS_WKV), 0, nullptr, scr, r / 64, r % 64, lane);
    }
    }
    } else {
    for (int r15 = 0; r15 < (PROBE_ID == 15 ? 2 : 1); ++r15)
    { f32x4 va[4][4], vb[4][4];
      int m = gw * 4;
      if (m < MTOK) rms_rows_load<4>(va, p.x + (size_t)m * DM, lane);
      for (; m < MTOK; m += NGW * 8) {
          const int m1 = m + NGW * 4, m2 = m + NGW * 8;
          if (m1 < MTOK) rms_rows_load<4>(vb, p.x + (size_t)m1 * DM, lane);
          rms_rows_store<4>(va, p.norm_mix_g, (bf16_t*)(ws + WS_XN) + (size_t)m * DM, lane);
          if (m2 < MTOK) rms_rows_load<4>(va, p.x + (size_t)m2 * DM, lane);
          if (m1 < MTOK) rms_rows_store<4>(vb, p.norm_mix_g, (bf16_t*)(ws + WS_XN) + (size_t)m1 * DM, lane);
      } }
    }
    }
    if (G != 256) late_transposes(p, lds, gw, NGW);
    { bf16_t* wt = (bf16_t*)(ws + WS_WIN) + (size_t)3072 * DM;
      for (int idx = blockIdx.x * 512 + tid; idx < 256 * DM; idx += G * 512) { const int r = idx >> 10, k = idx & 1023; float w = 0.f;
          if (r < 8) w = p.w_in[(size_t)k * 3096 + 1536 + r]; else if (r < 24) w = p.w_in[(size_t)k * 3096 + 2568 + (r - 8)];
          wt[idx] = f2bf(w); } }
    for (int m = gw; m < NBATCH * MEMLEN; m += NGW) { f32x4 v1[1][4]; rms_rows_load<1>(v1, p.mem + (size_t)m * DM, lane); rms_rows_store<1>(v1, p.norm_mem_g, (bf16_t*)(ws + WS_MEMN) + (size_t)m * DM, lane); }
}

constexpr int VT_PITCH = 72;
constexpr int L2_VT = 0, L2_KDT = 73728, L2_AUX = 110592, L2_DEC = 118784;
constexpr int VS_PITCH = 544;
DI void stage_vT(const bf16_t* proj, int tok0, LAS unsigned char* lds, int tid) {
    LAS bf16_t* vS = (LAS bf16_t*)(lds + L2_VT);
    u32x4 w[8];
#pragma unroll
    for (int i8 = 0; i8 < 8; ++i8) { const int piece = tid + 512 * i8, row = piece >> 6, cp = piece & 63; w[i8] = *(const u32x4*)(proj + (size_t)(tok0 + row) * NPROJ + C_GV + cp * 8); }
#pragma unroll
    for (int i8 = 0; i8 < 8; ++i8) { const int piece = tid + 512 * i8, row = piece >> 6, cp = piece & 63; *(LAS u32x4*)(vS + row * VS_PITCH + cp * 8) = w[i8]; }
}
template <int PITCH = VS_PITCH> DI bf16x8 vs_frag(const LAS bf16_t* vS, int row0, int rstep, int col0, int lane) {
    const LAS bf16_t* vp = vS + (row0 + ((lane & 15) >> 2)) * PITCH + col0 + 16 * ((lane >> 4) & 1) + 4 * (lane & 3);
    const s16x4 lo = __builtin_bit_cast(s16x4, __builtin_amdgcn_ds_read_tr16_b64_v4i16((LAS v4i16_t*)vp));
    const s16x4 hh = __builtin_bit_cast(s16x4, __builtin_amdgcn_ds_read_tr16_b64_v4i16((LAS v4i16_t*)(vp + rstep * PITCH)));
    return __builtin_shufflevector(lo, hh, 0, 1, 2, 3, 4, 5, 6, 7);
}
constexpr int KD_PITCH = 288;
DI void p2_unit(int chunk, const Params& p, LAS unsigned char* lds) {
    const int tid = get_tid(), lane = tid & 63, wid = __builtin_amdgcn_readfirstlane(tid >> 6), r32 = lane & 31, hi = lane >> 5;
    unsigned char* ws = p.ws;
    bf16_t* proj = (bf16_t*)(ws + WS_PROJ); const float* aux = (const float*)(ws + WS_AUX);
    const int b = chunk >> 7, n = chunk & 127, tok0 = chunk * 64;
    LAS bf16_t* vT = (LAS bf16_t*)(lds + L2_VT); LAS bf16_t* kdT = (LAS bf16_t*)(lds + L2_KDT); LAS float* auxs = (LAS float*)(lds + L2_AUX); LAS float* decs = (LAS float*)(lds + L2_DEC);
    stage_vT(proj, tok0, lds, tid);
    if (wid >= 4) { const int wj = wid - 4;
#pragma unroll
        for (int hh = 0; hh < 2; ++hh) { const int h = 2 * wj + hh;
            float v = logsig(aux[(size_t)(tok0 + lane) * 32 + h] + p.fox_b_f[h]) * LOG2E;
#pragma unroll
            for (int o = 1; o < 64; o <<= 1) { const float t = __shfl_up(v, o); if (lane >= o) v += t; }
            ((float*)(ws + WS_CLOC))[(size_t)(b * 8 + h) * SEQ + n * 64 + lane] = v;
            if (lane == 63) ((float*)(ws + WS_CTOT))[(b * 8 + h) * 128 + n] = v; } }
    { const int col = tid & 255, half = tid >> 8, t0 = 32 * half, t0u = __builtin_amdgcn_readfirstlane(t0);
      LAS float* tots = (LAS float*)(lds + L2_DEC) + 256;
      float w2c[16];
#pragma unroll
      for (int r = 0; r < 16; ++r) w2c[r] = p.gla_w2[r * 256 + col];
      const float bgc = p.gla_bg[col];
      bf16_t* pq = proj + (size_t)(tok0 + t0) * NPROJ + C_GQ + col; bf16_t* pk = proj + (size_t)(tok0 + t0) * NPROJ + C_GK + col;
      bf16_t qv32[32], kv32[32];
#pragma unroll
      for (int j2 = 0; j2 < 32; ++j2) { qv32[j2] = pq[(size_t)j2 * NPROJ]; kv32[j2] = pk[(size_t)j2 * NPROJ]; }
      float lc[32]; float bc = 0.f;
#pragma unroll
      for (int j2 = 0; j2 < 32; ++j2) { const f32x4* ar = (const f32x4*)(aux + (size_t)(tok0 + t0u + j2) * 32 + 8);
          float z = bgc;
#pragma unroll
          for (int r4 = 0; r4 < 4; ++r4) { const f32x4 a = ar[r4]; z += a.x * w2c[4 * r4] + a.y * w2c[4 * r4 + 1] + a.z * w2c[4 * r4 + 2] + a.w * w2c[4 * r4 + 3]; }
          bc += logsig_fast(z) * (1.0f / 16.0f); lc[j2] = bc; }
      if (half == 0) tots[col] = bc;
      __syncthreads();
      const float offs = half ? tots[col] : 0.f;
#pragma unroll
      for (int j2 = 0; j2 < 32; ++j2) { const float bcl = (offs + lc[j2]) * LOG2E;
          const float qd = bf2f(qv32[j2]) * 0.125f * __builtin_amdgcn_exp2f(bcl), kd = bf2f(kv32[j2]) * __builtin_amdgcn_exp2f(-bcl);
          const bf16_t kdb = f2bf(kd);
          pq[(size_t)j2 * NPROJ] = f2bf(qd); pk[(size_t)j2 * NPROJ] = kdb; kdT[(t0 + j2) * KD_PITCH + col] = kdb; }
      if (half) { const float dec = __builtin_amdgcn_exp2f((offs + bc) * LOG2E); decs[col] = dec; ((float*)(ws + WS_DECAY))[(size_t)(b * 128 + n) * 256 + col] = dec; }
    }
    __syncthreads();
    { const int h = wid >> 1, vb0 = (wid & 1) * 2, bh = b * 4 + h;
      f32x16 d[2][2];
#pragma unroll
      for (int i = 0; i < 2; ++i)
#pragma unroll
          for (int j = 0; j < 2; ++j)
#pragma unroll
              for (int e = 0; e < 16; ++e) d[i][j][e] = 0.f;
#pragma unroll
      for (int s = 0; s < 4; ++s) { bf16x8 a[2], bb[2];
#pragma unroll
          for (int i = 0; i < 2; ++i) a[i] = vs_frag(vT, 16 * s + 8 * hi, 4, h * 128 + 32 * (vb0 + i), lane);
#pragma unroll
          for (int j = 0; j < 2; ++j) bb[j] = vs_frag<KD_PITCH>(kdT, 16 * s + 8 * hi, 4, h * 64 + 32 * j, lane);
#pragma unroll
          for (int i = 0; i < 2; ++i)
#pragma unroll
              for (int j = 0; j < 2; ++j) d[i][j] = __builtin_amdgcn_mfma_f32_32x32x16_bf16(a[i], bb[j], d[i][j], 0, 0, 0); }
      float* dst = (float*)(ws + WS_DST) + ((size_t)bh * 128 + n) * 8192;
#pragma unroll
      for (int j = 0; j < 2; ++j) { const float dec = decs[h * 64 + 32 * j + r32];
#pragma unroll
          for (int i = 0; i < 2; ++i)
#pragma unroll
              for (int e = 0; e < 16; ++e) dst[(32 * (vb0 + i) + crow(e, hi)) * 64 + 32 * j + r32] = d[i][j][e] * dec; } }
    __syncthreads();
}

DI void gla_scan(const Params& p, int G, LAS unsigned char* lds) {
    const float* dST = (const float*)(p.ws + WS_DST); const float* decay = (const float*)(p.ws + WS_DECAY); bf16_t* SpT = (bf16_t*)(p.ws + WS_SPT);
    LAS float* dl = (LAS float*)lds;
    const int tid = get_tid();
    for (int e0 = blockIdx.x * 512; e0 < 16 * 8192; e0 += G * 512) {
        const int e = e0 + tid, bh = e0 >> 13, vk = e & 8191, k = e & 63, b = bh >> 2, h = bh & 3;
        __syncthreads();
#pragma unroll
        for (int i4 = 0; i4 < 4; ++i4) { const int idx = tid * 4 + 2048 * i4, n = idx >> 6, kk = idx & 63;
            *(LAS f32x4*)(dl + idx) = *(const f32x4*)(decay + (size_t)(b * 128 + n) * 256 + h * 64 + kk); }
        __syncthreads();
        const float* dp = dST + (size_t)bh * 128 * 8192 + vk; bf16_t* sp = SpT + (size_t)bh * 128 * 8192 + vk;
        float st = 0.f;
        for (int n0 = 0; n0 < 128; n0 += 64) { float dv[64];
#pragma unroll
            for (int j2 = 0; j2 < 64; ++j2) dv[j2] = __builtin_nontemporal_load(dp + (size_t)(n0 + j2) * 8192);
#pragma unroll
            for (int j2 = 0; j2 < 64; ++j2) { sp[(size_t)(n0 + j2) * 8192] = f2bf(st); st = dl[(n0 + j2) * 64 + k] * st + dv[j2]; } }
    }
    __syncthreads();
}

constexpr int FX_K = 0, FX_V = 36864, FX_CK = 73728, FX_CB = 74752, FX_AL = 75264, FX_TLO = 76288, FX_KP = 72;
DI void fx_init(f32x16& p0, f32x16& p1, const LAS float* ck, float cqm, int hi) {
#pragma unroll
    for (int g = 0; g < 4; ++g) { const f32x4 c0 = *(const LAS f32x4*)(ck + 8 * g + 4 * hi), c1 = *(const LAS f32x4*)(ck + 32 + 8 * g + 4 * hi);
#pragma unroll
        for (int e = 0; e < 4; ++e) { p0[4 * g + e] = cqm - c0[e]; p1[4 * g + e] = cqm - c1[e]; } }
}
DI void fx_qk(f32x16& p0, f32x16& p1, const LAS bf16_t* Kt, const bf16x8 (&qr)[4], int r32, int hi) {
#pragma unroll
    for (int ks = 0; ks < 4; ++ks) { const bf16x8 a0 = *(const LAS bf16x8*)(Kt + r32 * 72 + 16 * ks + 8 * hi), a1 = *(const LAS bf16x8*)(Kt + (32 + r32) * 72 + 16 * ks + 8 * hi);
        p0 = __builtin_amdgcn_mfma_f32_32x32x16_bf16(a0, qr[ks], p0, 0, 0, 0); p1 = __builtin_amdgcn_mfma_f32_32x32x16_bf16(a1, qr[ks], p1, 0, 0, 0); }
}
DI void fx_vfrag(bf16x8 (&vfr)[4][2], const LAS bf16_t* Vt, int lane, int hi) {
#pragma unroll
    for (int st = 0; st < 4; ++st)
#pragma unroll
        for (int db = 0; db < 2; ++db) { const LAS bf16_t* vp = Vt + (16 * st + 4 * hi + ((lane & 15) >> 2)) * 72 + 32 * db + 16 * ((lane >> 4) & 1) + 4 * (lane & 3);
            const s16x4 lo = __builtin_bit_cast(s16x4, __builtin_amdgcn_ds_read_tr16_b64_v4i16((LAS v4i16_t*)vp));
            const s16x4 hh = __builtin_bit_cast(s16x4, __builtin_amdgcn_ds_read_tr16_b64_v4i16((LAS v4i16_t*)(vp + 8 * 72)));
            vfr[st][db] = __builtin_shufflevector(lo, hh, 0, 1, 2, 3, 4, 5, 6, 7); }
}
template <bool PEND> DI void fx_softmax(f32x16& p0, f32x16& p1, f32x16& q0, f32x16& q1, bf16x8 (&pw)[4], f32x16 (&o)[2], float& m, float& l, float& cqm, float cq, LAS float* al,
                                        int k0, int qw0, int qrow, int r32, int hi) {
    if (k0 + 63 > qw0) {
#pragma unroll
        for (int i = 0; i < 16; ++i) { const int kv = k0 + crow(i, hi); if (kv > qrow) p0[i] = -INFINITY; if (kv + 32 > qrow) p1[i] = -INFINITY; } }
    float rm = fmaxf(fmaxf(p0[0], p1[0]), fmaxf(p0[1], p1[1]));
#pragma unroll
    for (int i = 2; i < 16; i += 2) { rm = fmaxf(fmaxf(rm, p0[i]), p1[i]); rm = fmaxf(fmaxf(rm, p0[i + 1]), p1[i + 1]); }
    rm = fmaxf(rm, __shfl_xor(rm, 32));
    if (__any(rm > 0.f)) {
        const float dl = fmaxf(rm, 0.f), alpha = __builtin_amdgcn_exp2f(-dl); l *= alpha; m += dl; cqm = cq - m;
#pragma unroll
        for (int i = 0; i < 16; ++i) { p0[i] -= dl; p1[i] -= dl; }
        if (PEND) {
#pragma unroll
            for (int i = 0; i < 16; ++i) { q0[i] -= dl; q1[i] -= dl; } }
        if (hi == 0) al[r32] = alpha;
        asm volatile("s_waitcnt lgkmcnt(0)" ::: "memory");
#pragma unroll
        for (int g = 0; g < 4; ++g) { const f32x4 a4 = *(const LAS f32x4*)(al + 8 * g + 4 * hi);
#pragma unroll
            for (int e = 0; e < 4; ++e) { o[0][4 * g + e] *= a4[e]; o[1][4 * g + e] *= a4[e]; } }
        asm volatile("" ::: "memory");
    }
#pragma unroll
    for (int i = 0; i < 16; ++i) { p0[i] = __builtin_amdgcn_exp2f(p0[i]); p1[i] = __builtin_amdgcn_exp2f(p1[i]); }
    { const f32x16 t = p0 + p1; const f32x4 u4 = (f32x4){t[0], t[1], t[2], t[3]} + (f32x4){t[4], t[5], t[6], t[7]} + (f32x4){t[8], t[9], t[10], t[11]} + (f32x4){t[12], t[13], t[14], t[15]};
      l += (u4.x + u4.y) + (u4.z + u4.w); }
#pragma unroll
    for (int s2 = 0; s2 < 2; ++s2) { u32x4 w0, w1;
#pragma unroll
        for (int e = 0; e < 4; ++e) { w0[e] = pk2(p0[8 * s2 + 2 * e], p0[8 * s2 + 2 * e + 1]); w1[e] = pk2(p1[8 * s2 + 2 * e], p1[8 * s2 + 2 * e + 1]); }
        pw[s2] = __builtin_bit_cast(bf16x8, w0); pw[2 + s2] = __builtin_bit_cast(bf16x8, w1); }
}
DI void fx_pv(f32x16 (&o)[2], const bf16x8 (&pw)[4], const bf16x8 (&vfr)[4][2]) {
#pragma unroll
    for (int st = 0; st < 4; ++st)
#pragma unroll
        for (int db = 0; db < 2; ++db) o[db] = __builtin_amdgcn_mfma_f32_32x32x16_bf16(pw[st], vfr[st][db], o[db], 0, 0, 0);
}
DI void fox_bh_setup(int bh, const Params& p, LAS unsigned char* lds) {
    const int tid = get_tid(), lane = tid & 63, wid = tid >> 6;
    LAS float* cbase = (LAS float*)(lds + FX_CB);
    const float* ct = (const float*)(p.ws + WS_CTOT) + bh * 128;
    __syncthreads();
    if (wid == 0) { const float v0 = ct[2 * lane], v1 = ct[2 * lane + 1], s = v0 + v1; float incl = s;
#pragma unroll
        for (int o = 1; o < 64; o <<= 1) { const float t = __shfl_up(incl, o); if (lane >= o) incl += t; }
        const float excl = incl - s; cbase[2 * lane] = excl; cbase[2 * lane + 1] = excl + v0; }
    __syncthreads();
}
DI void fox_unit(int bh, int qb, const Params& p, LAS unsigned char* lds, float thr2) {
    const int tid = get_tid(), lane = tid & 63, wid = __builtin_amdgcn_readfirstlane(tid >> 6), r32 = lane & 31, hi = lane >> 5;
    const bf16_t* proj = (const bf16_t*)(p.ws + WS_PROJ);
    const int b = bh >> 3, h = bh & 7, q0 = qb * 256; const size_t rowbase = (size_t)b * SEQ;
    LAS bf16_t* Kb = (LAS bf16_t*)(lds + FX_K); LAS bf16_t* Vb = (LAS bf16_t*)(lds + FX_V); LAS float* ckb = (LAS float*)(lds + FX_CK); LAS float* cbase = (LAS float*)(lds + FX_CB);
    LAS float* al = (LAS float*)(lds + FX_AL) + wid * 32; LAS int* tlo = (LAS int*)(lds + FX_TLO);
    const float* cl = (const float*)(p.ws + WS_CLOC) + (size_t)bh * SEQ;
#define FX_C2(t) (cbase[(t) >> 6] + cl[(t)])
    const int T_hi = q0 / 128 + 1;
    const int krow = tid & 127, chunk = tid >> 7;
    u32x4 kreg[2], vreg[2]; float ckreg = 0.f;
#define FX_LOAD(T) do { const bf16_t* rp = proj + (rowbase + 128 * (T) + krow) * NPROJ + h * 64 + chunk * 8; \
        kreg[0] = *(const u32x4*)(rp + C_FK); kreg[1] = *(const u32x4*)(rp + C_FK + 32); vreg[0] = *(const u32x4*)(rp + C_FV); vreg[1] = *(const u32x4*)(rp + C_FV + 32); \
        if (tid < 128) ckreg = FX_C2(128 * (T) + tid); } while (0)
#define FX_STORE(buf) do { _Pragma("unroll") for (int i_ = 0; i_ < 2; ++i_) { *(LAS u32x4*)(Kb + (buf) * 9216 + krow * FX_KP + (chunk + 4 * i_) * 8) = kreg[i_]; \
            *(LAS u32x4*)(Vb + (buf) * 9216 + krow * FX_KP + (chunk + 4 * i_) * 8) = vreg[i_]; } \
        if (tid < 128) ckb[(buf) * 128 + tid] = ckreg; } while (0)
    FX_LOAD(T_hi);
    const int qw0 = q0 + 32 * wid, qrow = qw0 + r32;
    bf16x8 qr[4];
#pragma unroll
    for (int ks = 0; ks < 4; ++ks) qr[ks] = *(const bf16x8*)(proj + (rowbase + qrow) * NPROJ + C_FQ + h * 64 + 16 * ks + 8 * hi);
    if (tid == 0) *tlo = q0 / 64;
    const float cq0 = FX_C2(q0), cq = FX_C2(qrow);
    const float cend = (tid < q0 / 64) ? FX_C2(64 * tid + 63) : 0.f;
    __syncthreads();
    if (tid < q0 / 64) { if (cq0 - cend >= -thr2) atomicMin((int*)tlo, tid); }
    FX_STORE(0);
    __syncthreads();
    const int t_lo = *tlo, T_lo = t_lo >> 1;
    float m = 0.f, l = 0.f, cqm = cq; f32x16 o[2];
#pragma unroll
    for (int e = 0; e < 16; ++e) { o[0][e] = 0.f; o[1][e] = 0.f; }
    for (int T = T_hi; T >= T_lo; --T) {
        const int buf = (T_hi - T) & 1;
        if (T > T_lo) FX_LOAD(T - 1);
        { const int k1 = 128 * T + 64, k0s = 128 * T;
          const LAS float* ckT = ckb + buf * 128; const LAS bf16_t* KtT = Kb + buf * 9216; const LAS bf16_t* VtT = Vb + buf * 9216;
          const bool act1 = (k1 <= qw0 + 31) && (2 * T + 1 >= t_lo), act0 = (k0s <= qw0 + 31) && (2 * T >= t_lo);
          if (act1 && act0) {
              f32x16 a0, a1, b0, b1; bf16x8 vfr[4][2], pw[4];
              fx_init(a0, a1, ckT + 64, cqm, hi); fx_init(b0, b1, ckT, cqm, hi);
              fx_qk(a0, a1, KtT + 64 * FX_KP, qr, r32, hi);
              fx_qk(b0, b1, KtT, qr, r32, hi);
              fx_vfrag(vfr, VtT + 64 * FX_KP, lane, hi);
              __builtin_amdgcn_sched_barrier(0);
              fx_softmax<true>(a0, a1, b0, b1, pw, o, m, l, cqm, cq, al, k1, qw0, qrow, r32, hi);
              __builtin_amdgcn_sched_barrier(0);
              fx_pv(o, pw, vfr);
              fx_vfrag(vfr, VtT, lane, hi);
              __builtin_amdgcn_sched_barrier(0);
              fx_softmax<false>(b0, b1, b0, b1, pw, o, m, l, cqm, cq, al, k0s, qw0, qrow, r32, hi);
              __builtin_amdgcn_sched_barrier(0);
              fx_pv(o, pw, vfr);
          } else if (act1 || act0) {
              const int sub = act1 ? 1 : 0, k0 = 128 * T + 64 * sub;
              f32x16 p0, p1; bf16x8 vfr[4][2], pw[4];
              fx_init(p0, p1, ckT + 64 * sub, cqm, hi);
              fx_qk(p0, p1, KtT + (64 * sub) * FX_KP, qr, r32, hi);
              fx_vfrag(vfr, VtT + (64 * sub) * FX_KP, lane, hi);
              __builtin_amdgcn_sched_barrier(0);
              fx_softmax<false>(p0, p1, p0, p1, pw, o, m, l, cqm, cq, al, k0, qw0, qrow, r32, hi);
              __builtin_amdgcn_sched_barrier(0);
              fx_pv(o, pw, vfr);
          }
        }
        if (T > T_lo) FX_STORE(buf ^ 1);
        __syncthreads();
    }
    l += __shfl_xor(l, 32);
    if (hi == 0) al[r32] = 1.0f / l;
    asm volatile("s_waitcnt lgkmcnt(0)" ::: "memory");
    bf16_t* mix = (bf16_t*)(p.ws + WS_MIX);
#pragma unroll
    for (int g = 0; g < 4; ++g) { const f32x4 a4 = *(const LAS f32x4*)(al + 8 * g + 4 * hi);
#pragma unroll
        for (int e = 0; e < 4; ++e) { const int i = 4 * g + e; bf16_t* orow = mix + (rowbase + qw0 + crow(i, hi)) * DM + h * 64 + r32;
            orow[0] = f2bf(o[0][i] * a4[e]); orow[32] = f2bf(o[1][i] * a4[e]); } }
#undef FX_C2
#undef FX_LOAD
#undef FX_STORE
}

DI void gla_out_unit(int chunk, const Params& p, LAS unsigned char* lds) {
    const int tid = get_tid(), lane = tid & 63, wid = __builtin_amdgcn_readfirstlane(tid >> 6), r32 = lane & 31, hi = lane >> 5;
    const bf16_t* proj = (const bf16_t*)(p.ws + WS_PROJ);
    const int b = chunk >> 7, n = chunk & 127, tok0 = chunk * 64;
    LAS bf16_t* vT = (LAS bf16_t*)(lds + L2_VT);
    const int h = wid >> 1, cb = wid & 1, bh = b * 4 + h, tok = tok0 + 32 * cb + r32;
    bf16x8 qf[4], kf[2][4], sf[4][4];
#pragma unroll
    for (int ks = 0; ks < 4; ++ks) qf[ks] = *(const bf16x8*)(proj + (size_t)tok * NPROJ + C_GQ + h * 64 + 16 * ks + 8 * hi);
#pragma unroll
    for (int sb = 0; sb < 2; ++sb)
#pragma unroll
        for (int ks = 0; ks < 4; ++ks) kf[sb][ks] = *(const bf16x8*)(proj + (size_t)(tok0 + 32 * sb + r32) * NPROJ + C_GK + h * 64 + 16 * ks + 8 * hi);
    const bf16_t* sp = (const bf16_t*)(p.ws + WS_SPT) + ((size_t)bh * 128 + n) * 8192;
#pragma unroll
    for (int vb = 0; vb < 4; ++vb)
#pragma unroll
        for (int ks = 0; ks < 4; ++ks) sf[vb][ks] = *(const bf16x8*)(sp + (32 * vb + r32) * 64 + 16 * ks + 8 * hi);
    u32x2 gwv[4][4];
#pragma unroll
    for (int vb = 0; vb < 4; ++vb)
#pragma unroll
        for (int g = 0; g < 4; ++g) gwv[vb][g] = *(const u32x2*)(proj + (size_t)tok * NPROJ + C_GR + h * 128 + 32 * vb + 8 * g + 4 * hi);
    stage_vT(proj, tok0, lds, tid);
    __syncthreads();
    f32x16 oT[4];
#pragma unroll
    for (int vb = 0; vb < 4; ++vb)
#pragma unroll
        for (int e = 0; e < 16; ++e) oT[vb][e] = 0.f;
#pragma unroll
    for (int vb = 0; vb < 4; ++vb)
#pragma unroll
        for (int ks = 0; ks < 4; ++ks) oT[vb] = __builtin_amdgcn_mfma_f32_32x32x16_bf16(sf[vb][ks], qf[ks], oT[vb], 0, 0, 0);
#pragma unroll
    for (int sb = 0; sb < 2; ++sb) {
        if (sb <= cb) {
        f32x16 X;
#pragma unroll
        for (int e = 0; e < 16; ++e) X[e] = 0.f;
#pragma unroll
        for (int ks = 0; ks < 4; ++ks) X = __builtin_amdgcn_mfma_f32_32x32x16_bf16(kf[sb][ks], qf[ks], X, 0, 0, 0);
        if (sb == cb) {
#pragma unroll
            for (int i = 0; i < 16; ++i) if (crow(i, hi) > r32) X[i] = 0.f; }
        bf16x8 xs[2];
#pragma unroll
        for (int s2 = 0; s2 < 2; ++s2) { u32x4 w;
#pragma unroll
            for (int e = 0; e < 4; ++e) w[e] = pk2(X[8 * s2 + 2 * e], X[8 * s2 + 2 * e + 1]);
            xs[s2] = __builtin_bit_cast(bf16x8, w); }
#pragma unroll
        for (int vb = 0; vb < 4; ++vb)
#pragma unroll
            for (int st = 0; st < 2; ++st) { const bf16x8 af = vs_frag(vT, 32 * sb + 16 * st + 4 * hi, 8, h * 128 + 32 * vb, lane);
                oT[vb] = __builtin_amdgcn_mfma_f32_32x32x16_bf16(af, xs[st], oT[vb], 0, 0, 0); }
        }
    }
    float ss = 0.f;
#pragma unroll
    for (int vb = 0; vb < 4; ++vb)
#pragma unroll
        for (int e = 0; e < 16; ++e) ss += oT[vb][e] * oT[vb][e];
    ss += __shfl_xor(ss, 32);
    const float rstd = rsqrtf(ss * (1.0f / 128.0f) + EPS);
    bf16_t* mix = (bf16_t*)(p.ws + WS_MIX);
#pragma unroll
    for (int vb = 0; vb < 4; ++vb)
#pragma unroll
        for (int g = 0; g < 4; ++g) { const int v0 = 32 * vb + 8 * g + 4 * hi;
            const u32x2 gw = gwv[vb][g];
            const f32x4 gn = *(const f32x4*)(p.gla_og + h * 128 + v0);
            float r[4] = {bflo(gw.x), bfhi(gw.x), bflo(gw.y), bfhi(gw.y)}; float ov[4];
#pragma unroll
            for (int e = 0; e < 4; ++e) { const float sg = r[e] / (1.0f + __expf(-r[e])); ov[e] = oT[vb][4 * g + e] * rstd * gn[e] * sg; }
            u32x2 w; w.x = pk2(ov[0], ov[1]); w.y = pk2(ov[2], ov[3]);
            *(u32x2*)(mix + (size_t)tok * DM + 512 + h * 128 + v0) = w; }
    __syncthreads();
}

#define XB_TMO      128
#define XB_XCNT(j)  (256  + 64 * (j))
#define XB_XSUB(j)  (1280 + 64 * (j))
#define XB_XGEN(j)  (2304 + 64 * (j))
#define XB_TOP      3328
#define XB_TOPGEN   3392
#define XCD_BAR_WORDS 3456
#define XB_SPIN_CAP (1u << 18)
DI unsigned xb_ld(unsigned* p)              { return __hip_atomic_load(p, __ATOMIC_RELAXED, __HIP_MEMORY_SCOPE_AGENT); }
DI unsigned xb_add(unsigned* p, unsigned v) { return __hip_atomic_fetch_add(p, v, __ATOMIC_RELAXED, __HIP_MEMORY_SCOPE_AGENT); }
DI unsigned xb_xcc_id() { return (unsigned)__builtin_amdgcn_s_getreg((3 << 11) | 20) & 0xFu; }
#define XB_SPIN(cond, bar) do { unsigned _sp = 0; while (cond) { __builtin_amdgcn_s_sleep(1); \
    if ((++_sp & 255u) == 0u) { if (xb_ld(&(bar)[XB_TMO])) break; if (_sp > XB_SPIN_CAP) { atomicAdd(&(bar)[XB_TMO], 1u); break; } } } } while (0)
struct XcdBarrier { unsigned* bar; unsigned x; volatile LAS unsigned* st; };
DI XcdBarrier xcd_barrier_post(unsigned* bar, volatile LAS unsigned* st) {
    XcdBarrier b; b.bar = bar; b.x = xb_xcc_id(); b.st = st;
    if (threadIdx.x == 0) (void)xb_add(&bar[XB_XCNT(b.x)], 1u);
    return b;
}
DI void xcd_barrier_complete(unsigned* bar, unsigned x, unsigned& nloc, unsigned& nx) {
    const unsigned G = gridDim.x * gridDim.y * gridDim.z;
    unsigned sum, cnt, mine, sp = 0u;
    for (;;) {
        sum = 0u; cnt = 0u; mine = 0u;
#pragma unroll
        for (unsigned j = 0; j < 16; ++j) { const unsigned c = xb_ld(&bar[XB_XCNT(j)]); sum += c; cnt += (c > 0u) ? 1u : 0u; mine = (j == x) ? c : mine; }
        if (sum == G) break;
        __builtin_amdgcn_s_sleep(1);
        if ((++sp & 255u) == 0u) { if (xb_ld(&bar[XB_TMO])) break; if (sp > XB_SPIN_CAP) { atomicAdd(&bar[XB_TMO], 1u); break; } }
    }
    nloc = mine > 0u ? mine : 1u; nx = cnt > 0u ? cnt : 1u;
}
DI void xcd_barrier(const XcdBarrier& b) {
    asm volatile("s_waitcnt vmcnt(0)" ::: "memory");
    __syncthreads();
    if (threadIdx.x == 0) {
        unsigned* bar = b.bar;
        __builtin_amdgcn_s_waitcnt(0);
        unsigned nloc = b.st[0], nx = b.st[1];
        if (nloc == 0u) { xcd_barrier_complete(bar, b.x, nloc, nx); b.st[0] = nloc; b.st[1] = nx; }
        const unsigned old = xb_add(&bar[XB_XSUB(b.x)], 1u);
        const unsigned gen = old / nloc;
        if (old + 1u == (gen + 1u) * nloc) {
            __builtin_amdgcn_fence(__ATOMIC_RELEASE, "agent");
            asm volatile("s_waitcnt vmcnt(0)" ::: "memory");
            const unsigned og = xb_add(&bar[XB_TOP], 1u);
            const unsigned tg = og / nx;
            if (og + 1u == (tg + 1u) * nx) xb_add(&bar[XB_TOPGEN], 1u);
            else XB_SPIN(xb_ld(&bar[XB_TOPGEN]) == tg, bar);
            __builtin_amdgcn_fence(__ATOMIC_ACQUIRE, "agent");
            xb_add(&bar[XB_XGEN(b.x)], 1u);
            asm volatile("s_waitcnt vmcnt(0)" ::: "memory");
        } else {
            XB_SPIN(xb_ld(&bar[XB_XGEN(b.x)]) == gen, bar);
            __builtin_amdgcn_fence(__ATOMIC_ACQUIRE, "agent");
            asm volatile("s_waitcnt vmcnt(0)" ::: "memory");
        }
    }
    __syncthreads();
}

__global__ void __launch_bounds__(512, 2) fwd_megakernel(Params p) {
    extern __shared__ __attribute__((aligned(16))) unsigned char lds_raw[];
    LAS unsigned char* lds = (LAS unsigned char*)lds_raw;
    cg::grid_group grid = cg::this_grid();
    const int G = gridDim.x, bx = blockIdx.x;
    unsigned char* ws = p.ws;
    bf16_t* proj = (bf16_t*)(ws + WS_PROJ);

    if (threadIdx.x < 2) ((volatile LAS unsigned*)(lds + MISC_OFF))[threadIdx.x] = 0u;
    __syncthreads();
    if (p.never) grid.sync();
    const XcdBarrier xbar = xcd_barrier_post((unsigned*)(ws + WS_BAR), (volatile LAS unsigned*)(lds + MISC_OFF));
#define GSYNC() xcd_barrier(xbar)
    for (int rep = 0; rep < (PROBE_ID == 3 ? 2 : 1); ++rep) { p0_prologue(p, lds, G); if (PROBE_ID == 3) GSYNC(); }
    GSYNC();
    if (PROBE_ID == 1) { for (int rep = 0; rep < 10; ++rep) GSYNC(); }
    for (int rep10 = 0; rep10 < (PROBE_ID == 10 ? 2 : 1); ++rep10) {
    for (int rep = 0; rep < (PROBE_ID == 2 ? 2 : 1); ++rep) {
    { pg8::Gemm g{(const bf16_t*)(ws + WS_XN), (const bf16_t*)(ws + WS_WIN)};
      pg8::StaticOrder S; S.init(MTOK, NPROJ, G, bx);
      pg8::EpiProj E{proj, (float*)(ws + WS_AUX), p.fox_q_g, p.fox_k_g};
      pg8::gemm_phase<pg8::GeoPlain<DM>>(lds, g, S, E); }
    { pg8::Gemm g{(const bf16_t*)(ws + WS_MEMN), (const bf16_t*)(ws + WS_WKV)};
      pg8::StaticOrder S; S.init(NBATCH * MEMLEN, 2 * DM, G, (bx + G / 2) % G);
      pg8::EpiNorm E{(bf16_t*)(ws + WS_KN), nullptr, p.xk_g, 1.0f, (bf16_t*)(ws + WS_VT)};
      pg8::gemm_phase<pg8::GeoPlain<DM>>(lds, g, S, E); }
    if (G == 256 && bx >= 160) { __syncthreads(); late_transposes(p, lds, (bx - 160) * 8 + (int)(threadIdx.x >> 6), (G - 160) * 8); }
    if (PROBE_ID == 2 && rep == 0) GSYNC(); }
    GSYNC();
    for (int c = bx; c < MTOK / 64; c += G) p2_unit(c, p, lds);
    GSYNC();
    }
    for (int rep = 0; rep < (PROBE_ID == 4 ? 2 : 1); ++rep) {
    { pg8::Gemm g{(const bf16_t*)(ws + WS_WO), (const bf16_t*)(ws + WS_VT)};
      pg8::StaticOrder S; S.init(DM, 4 * DM, G, (G == 256) ? ((((bx >> 3) & 7) <= 1) ? ((bx & 7) + 8 * ((bx >> 3) & 7) + 16 * (bx >> 6)) : 64 + bx) : bx);
      pg8::EpiBf<4 * DM, 0, false, -1> E{(bf16_t*)(ws + WS_VWT), nullptr, nullptr};
      pg8::gemm_phase<pg8::Geo<256, DM, DM, 256, 256, 0, 0, 2, 256L * DM>>(lds, g, S, E); }
    for (int r11 = 0; r11 < (PROBE_ID == 11 ? 2 : 1); ++r11) gla_scan(p, G, lds);
    { const int tl = get_tid() & 63; float gq = fabsf(p.fox_q_g[tl]), gk = fabsf(p.fox_k_g[tl]);
#pragma unroll
      for (int o = 1; o < 64; o <<= 1) { gq = fmaxf(gq, __shfl_xor(gq, o)); gk = fmaxf(gk, __shfl_xor(gk, o)); }
      const float bqk = 64.0f * gq * gk * 0.125f * LOG2E * 1.02f, thr2 = 150.0f + bqk;
      if (G == 256) { const int bh = (bx & 7) * 4 + (bx >> 6), j = (bx >> 3) & 7;
          fox_bh_setup(bh, p, lds);
          for (int i = 3; i >= 0; --i) fox_unit(bh, j + 8 * i, p, lds, thr2); }
      else { for (int u = bx; u < 1024; u += G) { fox_bh_setup(u >> 5, p, lds); fox_unit(u >> 5, u & 31, p, lds, thr2); } } }
    if (PROBE_ID == 4 && rep == 0) GSYNC(); }
    GSYNC();
    for (int rep = 0; rep < (PROBE_ID == 5 ? 2 : 1); ++rep) {
    for (int c = bx; c < MTOK / 64; c += G) gla_out_unit(c, p, lds);
    if (PROBE_ID == 5 && rep == 0) GSYNC(); }
    GSYNC();
    { pg8::Gemm g{(const bf16_t*)(ws + WS_MIX), (const bf16_t*)(ws + WS_WOUT)};
      pg8::StaticOrder S; S.init(MTOK, DM, G, bx);
      pg8::EpiRes<false, false, true> E{p.x, nullptr, (bf16_t*)(ws + WS_HB), (float*)(ws + WS_SUMSQ1)};
      pg8::gemm_phase<pg8::GeoPlain<DM>>(lds, g, S, E); }
    GSYNC();
    for (int rep = 0; rep < (PROBE_ID == 6 ? 2 : 1); ++rep) {
    { pg8::Gemm g{(const bf16_t*)(ws + WS_HB), (const bf16_t*)(ws + WS_WQ)};
      pg8::StaticOrder S; S.init(MTOK, DM, G, bx);
      pg8::EpiNorm E{(bf16_t*)(ws + WS_QN), (const float*)(ws + WS_SUMSQ1), p.xq_g, 1.0f / 16.0f, nullptr};
      pg8::gemm_phase<pg8::GeoPlain<DM>>(lds, g, S, E); }
    if (PROBE_ID == 6 && rep == 0) GSYNC(); }
    GSYNC();
    for (int rep = 0; rep < (PROBE_ID == 7 ? 2 : 1); ++rep) {
    { pg8::Gemm g{(const bf16_t*)(ws + WS_QN), (const bf16_t*)(ws + WS_KN)};
      pg8::StaticOrder S; S.init(MTOK, DM, G, bx);
      pg8::EpiSoftmax E{(bf16_t*)(ws + WS_P)};
      pg8::gemm_phase<pg8::Geo<256, DM, DM, 256, 256, 256L * DM, 5>>(lds, g, S, E); }
    if (PROBE_ID == 7 && rep == 0) GSYNC(); }
    GSYNC();
    { pg8::Gemm g{(const bf16_t*)(ws + WS_P), (const bf16_t*)(ws + WS_VWT)};
      pg8::StaticOrder S; S.init(MTOK, DM, G, bx);
      pg8::EpiRes<true, false, true> E{(const void*)(ws + WS_HB), nullptr, (bf16_t*)(ws + WS_HB), (float*)(ws + WS_SUMSQ2)};
      pg8::gemm_phase<pg8::Geo<DM, DM, 4 * DM, 0, 256L * 4 * DM, DM, 5>>(lds, g, S, E); }
    GSYNC();
    for (int rep = 0; rep < (PROBE_ID == 9 ? 2 : 1); ++rep) {
    { pg8::Gemm g{(const bf16_t*)(ws + WS_HB), (const bf16_t*)(ws + WS_W1)};
      pg8::StaticOrder S; S.init(MTOK, FF, G, bx);
      pg8::EpiBf<FF, 1, true, -1> E{(bf16_t*)(ws + WS_U), (const float*)(ws + WS_SUMSQ2), nullptr};
      pg8::gemm_phase<pg8::GeoPlain<DM>>(lds, g, S, E); }
    if (PROBE_ID == 9 && rep == 0) GSYNC(); }
    GSYNC();
    { pg8::Gemm g{(const bf16_t*)(ws + WS_U), (const bf16_t*)(ws + WS_W2)};
      pg8::StaticOrder S; S.init(MTOK, DM, G, bx);
      pg8::EpiRes<true, true, false> E{(const void*)(ws + WS_HB), p.out, nullptr, nullptr};
      pg8::gemm_phase<pg8::GeoPlain<FF>>(lds, g, S, E); }
}

extern "C" void kernel_launch(void* const* d_in, const int* in_sizes, int n_in, void* d_out, int out_size, void* d_ws, size_t ws_size, hipStream_t stream) {
    static int grid = 0;
    if (grid == 0) {
        int dev = 0, cus = 0, per_cu = 0;
        hipGetDevice(&dev);
        hipDeviceGetAttribute(&cus, hipDeviceAttributeMultiprocessorCount, dev);
        hipFuncSetAttribute((const void*)fwd_megakernel, hipFuncAttributeMaxDynamicSharedMemorySize, LDS_BYTES);
        hipOccupancyMaxActiveBlocksPerMultiprocessor(&per_cu, (const void*)fwd_megakernel, 512, LDS_BYTES);
        if (per_cu < 1) { fprintf(stderr, "kernel_launch: occupancy query reports %d blocks per CU\n", per_cu); per_cu = 1; }
        if (per_cu > 1) per_cu = 1;
        grid = cus * per_cu;
        if (ws_size < WS_END) { fprintf(stderr, "kernel_launch: workspace too small (%zu < %zu)\n", ws_size, (size_t)WS_END); grid = -1; }
    }
    if (grid < 0) return;
    Params p{};
    const float** pp = (const float**)&p;
    for (int i = 0; i < 21; ++i) pp[i] = (const float*)d_in[i];
    p.out = (float*)d_out; p.ws = (unsigned char*)d_ws;
    p.never = 0;
    if (hipMemsetAsync((char*)d_ws + WS_BAR, 0, XCD_BAR_WORDS * 4, stream) != hipSuccess) { fprintf(stderr, "kernel_launch: memset of the barrier words failed\n"); return; }
    void* args[] = {&p};
    hipError_t e = hipLaunchCooperativeKernel((const void*)fwd_megakernel, dim3(grid), dim3(512), args, LDS_BYTES, stream);
    if (e != hipSuccess) fprintf(stderr, "cooperative launch failed: %s (grid %d)\n", hipGetErrorString(e), grid);
}
```

```cpp
#define PROBE_ID 0
#include <hip/hip_runtime.h>
#include <hip/hip_cooperative_groups.h>
#include <cstdio>
#include <cstdint>
namespace cg = cooperative_groups;

#define LAS __attribute__((address_space(3)))
#define DI __device__ __forceinline__
typedef unsigned short bf16_t;
typedef short bf16x8 __attribute__((ext_vector_type(8)));
typedef short s16x4 __attribute__((ext_vector_type(4)));
typedef float f32x4 __attribute__((ext_vector_type(4)));
typedef float f32x2 __attribute__((ext_vector_type(2)));
typedef float f32x16 __attribute__((ext_vector_type(16)));
typedef unsigned u32x4 __attribute__((ext_vector_type(4)));
typedef unsigned u32x2 __attribute__((ext_vector_type(2)));
typedef __bf16 bf16x2_t __attribute__((ext_vector_type(2)));
typedef short v4i16_t __attribute__((ext_vector_type(4)));

DI unsigned pk2(float lo, float hi) { f32x2 v = {lo, hi}; bf16x2_t b = __builtin_convertvector(v, bf16x2_t); return __builtin_bit_cast(unsigned, b); }
DI float bf2f(bf16_t u) { return __uint_as_float(((unsigned)u) << 16); }
DI float bflo(unsigned w) { return __uint_as_float(w << 16); }
DI float bfhi(unsigned w) { return __uint_as_float(w & 0xffff0000u); }
DI bf16_t f2bf(float f) { return (bf16_t)(pk2(f, 0.f) & 0xffffu); }
DI int get_tid() { int t = threadIdx.x; asm volatile("" : "+v"(t)); return t; }
DI int crow(int r, int hi) { return (r & 3) + 8 * (r >> 2) + 4 * hi; }
#define BAR_LDS() do { asm volatile("s_waitcnt lgkmcnt(0)" ::: "memory"); __builtin_amdgcn_s_barrier(); asm volatile("" ::: "memory"); } while (0)

constexpr int DM = 1024, NBATCH = 4, SEQ = 8192, MTOK = NBATCH * SEQ, NPROJ = 3328, FF = 4096, MEMLEN = 256;
constexpr int C_FQ = 0, C_FK = 512, C_FV = 1024, C_GQ = 1536, C_GK = 1792, C_GV = 2048, C_GR = 2560;
constexpr float EPS = 1e-6f, LOG2E = 1.4426950408889634f;
constexpr int RED_OFF = 131072;
constexpr int MISC_OFF = 131072 + 8192;
constexpr int LDS_BYTES = 131072 + 8192 + 1024;

namespace pg8 {
constexpr int BM = 256, BK = 64, HALF = 128, HTB = HALF * BK * 2, STAGE_BYTES = 8 * HTB, NXCD = 8, WGM = 4;
__host__ __device__ __forceinline__ int lds_byte(int r, int c) { const int st = (r >> 4) * 2 + (c >> 5), rr = r & 15, cc = c & 31, ob = rr * 64 + cc * 2; return st * 1024 + (ob ^ (((ob >> 9) & 1) << 5)); }
__host__ __device__ __forceinline__ void stage_rc(int b, int& R, int& C) { const int st = b / 1024, sb = b % 1024, swz = sb ^ (((sb >> 9) & 1) << 5); R = (st >> 1) * 16 + swz / 64; C = (st & 1) * 32 + (swz % 64) / 2; }
__host__ __device__ __forceinline__ int perm32(int rho) { const int n = rho >> 4, i = rho & 15; return 8 * (i >> 2) + 4 * n + (i & 3); }

struct Unit { int pm, pn; };
struct Gemm { const bf16_t* A; const bf16_t* Bt; };
template <int K_, int LDA_, int LDB_, long APN_, long BPN_, long BBATCH_, int BSHIFT_, int PNBITS_ = 30, long BPNHI_ = 0> struct Geo { static constexpr int K = K_, LDA = LDA_, LDB = LDB_, BSHIFT = BSHIFT_, PNBITS = PNBITS_; static constexpr long APN = APN_, BPN = BPN_, BBATCH = BBATCH_, BPNHI = BPNHI_; };
template <int K_> using GeoPlain = Geo<K_, K_, K_, 0, 256L * K_, 0, 0>;

struct StaticOrder {
    int nM, nN, nwg, G, c;
    __host__ __device__ void init(int M, int N, int G_, int c_) { nM = M / BM; nN = N / BM; nwg = nM * nN; G = G_; c = c_; }
    __host__ __device__ bool next(int i, Unit& u) const {
        const long L = (long)i * G + c; if (L >= nwg) return false;
        int wgid = (int)L; { const int q = nwg / NXCD, r = nwg % NXCD, xcd = wgid % NXCD, off = wgid / NXCD; wgid = (xcd < r ? xcd * (q + 1) : r * (q + 1) + (xcd - r) * q) + off; }
        const int nig = WGM * nN, gid = wgid / nig, fm = gid * WGM, gsz = (nM - fm) < WGM ? (nM - fm) : WGM;
        u.pm = fm + ((wgid % nig) % gsz); u.pn = (wgid % nig) / gsz; return true;
    }
};

typedef f32x4 Acc[2][2][4][2];

template <bool ISMAX> DI void tile_row_reduce(float (&p)[2][4], LAS float* red, int wr, int wc, int fr, int fq) {
#pragma unroll
    for (int ai = 0; ai < 2; ++ai)
#pragma unroll
        for (int m = 0; m < 4; ++m) { float v = p[ai][m]; const float a = __shfl_xor(v, 16); v = ISMAX ? fmaxf(v, a) : v + a; const float b = __shfl_xor(v, 32); v = ISMAX ? fmaxf(v, b) : v + b;
            if (fq == 0) red[(ai * 128 + wr * 64 + m * 16 + fr) * 4 + wc] = v; }
    BAR_LDS();
#pragma unroll
    for (int ai = 0; ai < 2; ++ai)
#pragma unroll
        for (int m = 0; m < 4; ++m) { const f32x4 q = *(const LAS f32x4*)(red + (ai * 128 + wr * 64 + m * 16 + fr) * 4);
            p[ai][m] = ISMAX ? fmaxf(fmaxf(q.x, q.y), fmaxf(q.z, q.w)) : (q.x + q.y) + (q.z + q.w); }
}

template <bool BASE_BF16, bool OUT_F32, bool OUT_BF16> struct EpiRes {
    static constexpr bool PERM = true;
    const void* base; float* out; bf16_t* hb; float* sumsq;
    DI void operator()(Acc& acc, const Unit& u, int wr, int wc, int fr, int fq, LAS unsigned char* lds) const {
        const int col0 = u.pn * BM + wc * 32 + 8 * fq;
        float part[2][4];
#pragma unroll
        for (int ai = 0; ai < 2; ++ai)
#pragma unroll
            for (int m = 0; m < 4; ++m) { const int row = u.pm * BM + ai * HALF + wr * 64 + m * 16 + fr; const size_t off = (size_t)row * DM + col0; float ss = 0.f;
#pragma unroll
                for (int bj = 0; bj < 2; ++bj) { const size_t o = off + bj * HALF;
                    f32x4 b0, b1;
                    if (BASE_BF16) { const u32x4 w = *(const u32x4*)((const bf16_t*)base + o); b0 = (f32x4){bflo(w.x), bfhi(w.x), bflo(w.y), bfhi(w.y)}; b1 = (f32x4){bflo(w.z), bfhi(w.z), bflo(w.w), bfhi(w.w)}; }
                    else { b0 = *(const f32x4*)((const float*)base + o); b1 = *(const f32x4*)((const float*)base + o + 4); }
                    const f32x4 v0 = b0 + acc[ai][bj][m][0], v1 = b1 + acc[ai][bj][m][1];
                    if (OUT_F32) { *(f32x4*)(out + o) = v0; *(f32x4*)(out + o + 4) = v1; }
                    if (OUT_BF16) { u32x4 w; w.x = pk2(v0.x, v0.y); w.y = pk2(v0.z, v0.w); w.z = pk2(v1.x, v1.y); w.w = pk2(v1.z, v1.w); *(u32x4*)(hb + o) = w;
                        ss += ((v0.x * v0.x + v0.y * v0.y) + (v0.z * v0.z + v0.w * v0.w)) + ((v1.x * v1.x + v1.y * v1.y) + (v1.z * v1.z + v1.w * v1.w)); } }
                part[ai][m] = ss; }
        if (OUT_BF16) {
            tile_row_reduce<false>(part, (LAS float*)(lds + RED_OFF), wr, wc, fr, fq);
            if (wc == 0 && fq == 0) {
#pragma unroll
                for (int ai = 0; ai < 2; ++ai)
#pragma unroll
                    for (int m = 0; m < 4; ++m) sumsq[(size_t)(u.pm * BM + ai * HALF + wr * 64 + m * 16 + fr) * 4 + u.pn] = part[ai][m]; }
        }
    }
};
template <int ldc, int act, bool HAS_RS, int aux_pn> struct EpiBf {
    static constexpr bool PERM = true;
    bf16_t* O; const float* sumsq; float* aux;
    DI void operator()(Acc& acc, const Unit& u, int wr, int wc, int fr, int fq, LAS unsigned char*) const {
        if (aux_pn >= 0 && u.pn == aux_pn) {
            if (wc == 0) {
#pragma unroll
                for (int ai = 0; ai < 2; ++ai)
#pragma unroll
                    for (int m = 0; m < 4; ++m) { const int row = u.pm * BM + ai * HALF + wr * 64 + m * 16 + fr;
#pragma unroll
                        for (int n = 0; n < 2; ++n) *(f32x4*)(aux + (size_t)row * 32 + 8 * fq + 4 * n) = acc[ai][0][m][n]; } }
            return; }
        const int col0 = u.pn * BM + wc * 32 + 8 * fq;
#pragma unroll
        for (int ai = 0; ai < 2; ++ai)
#pragma unroll
            for (int m = 0; m < 4; ++m) { const int row = u.pm * BM + ai * HALF + wr * 64 + m * 16 + fr; bf16_t* rowp = O + (size_t)row * ldc + col0;
                float rs = 1.0f; if (HAS_RS) { const f32x4 q4 = *(const f32x4*)(sumsq + (size_t)row * 4); rs = rsqrtf(((q4.x + q4.y) + (q4.z + q4.w)) * (1.0f / DM) + EPS); }
#pragma unroll
                for (int bj = 0; bj < 2; ++bj) { f32x4 v0 = acc[ai][bj][m][0] * rs, v1 = acc[ai][bj][m][1] * rs;
                    if (act) { v0 = __builtin_elementwise_max(v0, (f32x4){0.f, 0.f, 0.f, 0.f}); v1 = __builtin_elementwise_max(v1, (f32x4){0.f, 0.f, 0.f, 0.f}); v0 = v0 * v0; v1 = v1 * v1; }
                    u32x4 w; w.x = pk2(v0.x, v0.y); w.y = pk2(v0.z, v0.w); w.z = pk2(v1.x, v1.y); w.w = pk2(v1.z, v1.w);
                    if (act) __builtin_nontemporal_store(w, (u32x4*)(rowp + bj * HALF)); else *(u32x4*)(rowp + bj * HALF) = w; } }
    }
};
struct EpiProj {
    static constexpr bool PERM = true;
    bf16_t* O; float* aux; const float* gq; const float* gk;
    DI void operator()(Acc& acc, const Unit& u, int wr, int wc, int fr, int fq, LAS unsigned char* lds) const {
        if (u.pn == 12) {
            if (wc == 0) {
#pragma unroll
                for (int ai = 0; ai < 2; ++ai)
#pragma unroll
                    for (int m = 0; m < 4; ++m) { const int row = u.pm * BM + ai * HALF + wr * 64 + m * 16 + fr;
#pragma unroll
                        for (int n = 0; n < 2; ++n) *(f32x4*)(aux + (size_t)row * 32 + 8 * fq + 4 * n) = acc[ai][0][m][n]; } }
            return; }
        const int col0 = u.pn * BM + wc * 32 + 8 * fq;
        if (u.pn < 4) {
            LAS float* red = (LAS float*)(lds + RED_OFF);
#pragma unroll
            for (int ai = 0; ai < 2; ++ai)
#pragma unroll
                for (int m = 0; m < 4; ++m)
#pragma unroll
                    for (int bj = 0; bj < 2; ++bj) { const f32x4 v0 = acc[ai][bj][m][0], v1 = acc[ai][bj][m][1];
                        float ss = ((v0.x * v0.x + v0.y * v0.y) + (v0.z * v0.z + v0.w * v0.w)) + ((v1.x * v1.x + v1.y * v1.y) + (v1.z * v1.z + v1.w * v1.w));
                        ss += __shfl_xor(ss, 16); ss += __shfl_xor(ss, 32);
                        if (fq == 0) red[(ai * 128 + wr * 64 + m * 16 + fr) * 8 + bj * 4 + wc] = ss; }
            BAR_LDS();
            const bool isk = u.pn >= 2; const float* g = (isk ? gk : gq) + 32 * (wc & 1) + 8 * fq; const float sc = isk ? 1.0f : 0.125f * LOG2E;
            const f32x4 g0 = *(const f32x4*)g, g1 = *(const f32x4*)(g + 4);
#pragma unroll
            for (int ai = 0; ai < 2; ++ai)
#pragma unroll
                for (int m = 0; m < 4; ++m) { const int rl = ai * HALF + wr * 64 + m * 16 + fr; bf16_t* rowp = O + (size_t)(u.pm * BM + rl) * NPROJ + col0;
#pragma unroll
                    for (int bj = 0; bj < 2; ++bj) { const f32x2 pr = *(const LAS f32x2*)(red + rl * 8 + bj * 4 + (wc & 2)); const float tot = pr.x + pr.y; const float rs = rsqrtf(tot * (1.0f / 64.0f) + EPS) * sc;
                        const f32x4 v0 = acc[ai][bj][m][0] * rs * g0, v1 = acc[ai][bj][m][1] * rs * g1;
                        u32x4 w; w.x = pk2(v0.x, v0.y); w.y = pk2(v0.z, v0.w); w.z = pk2(v1.x, v1.y); w.w = pk2(v1.z, v1.w); *(u32x4*)(rowp + bj * HALF) = w; } }
            return; }
#pragma unroll
        for (int ai = 0; ai < 2; ++ai)
#pragma unroll
            for (int m = 0; m < 4; ++m) { const int row = u.pm * BM + ai * HALF + wr * 64 + m * 16 + fr; bf16_t* rowp = O + (size_t)row * NPROJ + col0;
#pragma unroll
                for (int bj = 0; bj < 2; ++bj) { const f32x4 v0 = acc[ai][bj][m][0], v1 = acc[ai][bj][m][1];
                    u32x4 w; w.x = pk2(v0.x, v0.y); w.y = pk2(v0.z, v0.w); w.z = pk2(v1.x, v1.y); w.w = pk2(v1.z, v1.w); *(u32x4*)(rowp + bj * HALF) = w; } }
    }
};
struct EpiNorm {
    static constexpr bool PERM = true;
    bf16_t* O; const float* sumsq; const float* gain; float scale; bf16_t* vt;
    DI void operator()(Acc& acc, const Unit& u, int wr, int wc, int fr, int fq, LAS unsigned char* lds) const {
        if (vt && u.pn >= 4) {
#pragma unroll
            for (int ai = 0; ai < 2; ++ai)
#pragma unroll
                for (int m = 0; m < 4; ++m) { const int row = u.pm * BM + ai * HALF + wr * 64 + m * 16 + fr; bf16_t* rowp = vt + (size_t)row * DM + (u.pn - 4) * BM + wc * 32 + 8 * fq;
#pragma unroll
                    for (int bj = 0; bj < 2; ++bj) { const f32x4 v0 = acc[ai][bj][m][0], v1 = acc[ai][bj][m][1];
                        u32x4 w; w.x = pk2(v0.x, v0.y); w.y = pk2(v0.z, v0.w); w.z = pk2(v1.x, v1.y); w.w = pk2(v1.z, v1.w); *(u32x4*)(rowp + bj * HALF) = w; } }
            return; }
        LAS float* red = (LAS float*)(lds + RED_OFF);
        float part[2][4];
#pragma unroll
        for (int ai = 0; ai < 2; ++ai)
#pragma unroll
            for (int m = 0; m < 4; ++m) { const int row = u.pm * BM + ai * HALF + wr * 64 + m * 16 + fr;
                float rs = 1.0f; if (sumsq) { const f32x4 q4 = *(const f32x4*)(sumsq + (size_t)row * 4); rs = rsqrtf(((q4.x + q4.y) + (q4.z + q4.w)) * (1.0f / DM) + EPS); } float ss = 0.f;
#pragma unroll
                for (int bj = 0; bj < 2; ++bj)
#pragma unroll
                    for (int n = 0; n < 2; ++n) { const f32x4 v = acc[ai][bj][m][n] * rs; acc[ai][bj][m][n] = v; ss += (v.x * v.x + v.y * v.y) + (v.z * v.z + v.w * v.w); }
                part[ai][m] = ss; }
        tile_row_reduce<false>(part, red, wr, wc, fr, fq);
        const int cin = wc * 32 + 8 * fq;
#pragma unroll
        for (int ai = 0; ai < 2; ++ai)
#pragma unroll
            for (int m = 0; m < 4; ++m) { const int row = u.pm * BM + ai * HALF + wr * 64 + m * 16 + fr; const float rn = rsqrtf(part[ai][m] * (1.0f / 256.0f) + EPS) * scale;
                bf16_t* rowp = O + (size_t)row * DM + u.pn * BM + cin;
#pragma unroll
                for (int bj = 0; bj < 2; ++bj) { const f32x4 g0 = *(const f32x4*)(gain + bj * HALF + cin), g1 = *(const f32x4*)(gain + bj * HALF + cin + 4);
                    const f32x4 v0 = acc[ai][bj][m][0] * rn * g0, v1 = acc[ai][bj][m][1] * rn * g1;
                    u32x4 w; w.x = pk2(v0.x, v0.y); w.y = pk2(v0.z, v0.w); w.z = pk2(v1.x, v1.y); w.w = pk2(v1.z, v1.w); *(u32x4*)(rowp + bj * HALF) = w; } }
    }
};
struct EpiSoftmax {
    static constexpr bool PERM = true;
    bf16_t* O;
    DI void operator()(Acc& acc, const Unit& u, int wr, int wc, int fr, int fq, LAS unsigned char* lds) const {
        LAS float* red = (LAS float*)(lds + RED_OFF);
        float part[2][4];
#pragma unroll
        for (int ai = 0; ai < 2; ++ai)
#pragma unroll
            for (int m = 0; m < 4; ++m) { float mx = -3.0e38f;
#pragma unroll
                for (int bj = 0; bj < 2; ++bj)
#pragma unroll
                    for (int n = 0; n < 2; ++n) { const f32x4 v = acc[ai][bj][m][n]; mx = fmaxf(mx, fmaxf(fmaxf(v.x, v.y), fmaxf(v.z, v.w))); }
                part[ai][m] = mx; }
        tile_row_reduce<true>(part, red, wr, wc, fr, fq);
        float part2[2][4];
#pragma unroll
        for (int ai = 0; ai < 2; ++ai)
#pragma unroll
            for (int m = 0; m < 4; ++m) { const float mx = part[ai][m] * LOG2E; float s = 0.f;
#pragma unroll
                for (int bj = 0; bj < 2; ++bj)
#pragma unroll
                    for (int n = 0; n < 2; ++n) { f32x4 v = acc[ai][bj][m][n];
#pragma unroll
                        for (int e = 0; e < 4; ++e) { v[e] = __builtin_amdgcn_exp2f(v[e] * LOG2E - mx); s += v[e]; }
                        acc[ai][bj][m][n] = v; }
                part2[ai][m] = s; }
        tile_row_reduce<false>(part2, red + 1024, wr, wc, fr, fq);
        const int cin = wc * 32 + 8 * fq;
#pragma unroll
        for (int ai = 0; ai < 2; ++ai)
#pragma unroll
            for (int m = 0; m < 4; ++m) { const int row = u.pm * BM + ai * HALF + wr * 64 + m * 16 + fr; const float inv = 1.0f / part2[ai][m];
                bf16_t* rowp = O + (size_t)row * DM + u.pn * BM + cin;
#pragma unroll
                for (int bj = 0; bj < 2; ++bj) { const f32x4 v0 = acc[ai][bj][m][0] * inv, v1 = acc[ai][bj][m][1] * inv;
                    u32x4 w; w.x = pk2(v0.x, v0.y); w.y = pk2(v0.z, v0.w); w.z = pk2(v1.x, v1.y); w.w = pk2(v1.z, v1.w); *(u32x4*)(rowp + bj * HALF) = w; } }
    }
};

template <class GEO, class Epi>
__device__ __forceinline__ void gemm_phase(LAS unsigned char* lds, const Gemm g, const StaticOrder& S, const Epi& E) {
    const int tid = get_tid(), wid = __builtin_amdgcn_readfirstlane(tid >> 6), lane = tid & 63, wr = wid >> 2, wc = wid & 3, fr = lane & 15, fq = lane >> 4;
    constexpr int K = GEO::K, nt = K / BK;
    unsigned voffA[2], voffB[2];
#pragma unroll
    for (int i = 0; i < 2; ++i) { int R, C; stage_rc(tid * 16 + i * 8192, R, C); const int Rb = Epi::PERM ? ((R & ~31) + perm32(R & 31)) : R;
        voffA[i] = (unsigned)(R * GEO::LDA + C) * 2u; voffB[i] = (unsigned)(Rb * GEO::LDB + C) * 2u; }
    const size_t kstep = (size_t)(BK * 2);
    constexpr size_t hstepA = (size_t)HALF * GEO::LDA * 2, hstepB = (size_t)HALF * GEO::LDB * 2;
    const unsigned ldsw = (unsigned)wid * 1024u;
    const int aoff = lds_byte(wr * 64 + fr, fq * 8), boff = lds_byte(wc * 32 + fr, fq * 8);
#define PG8_SA(b, h) (((b) * 2 + (h)) * HTB)
#define PG8_SB(b, h) ((4 + (b) * 2 + (h)) * HTB)
#define PG8_STAGE(bufoff, gbase, voff) do { _Pragma("unroll") for (int _i = 0; _i < 2; ++_i) \
        __builtin_amdgcn_global_load_lds((const unsigned*)((const char*)(gbase) + (voff)[_i]), (LAS unsigned*)(lds + (bufoff) + ldsw + _i * 8192), 16, 0, 0); } while (0)
#define PG8_LDA(dst, b, h) do { _Pragma("unroll") for (int m = 0; m < 4; ++m) _Pragma("unroll") for (int k = 0; k < 2; ++k) dst[m][k] = *(const LAS bf16x8*)(lds + PG8_SA(b, h) + aoff + m * 2048 + k * 1024); } while (0)
#define PG8_LDB(dst, b, h) do { _Pragma("unroll") for (int n = 0; n < 2; ++n) _Pragma("unroll") for (int k = 0; k < 2; ++k) dst[n][k] = *(const LAS bf16x8*)(lds + PG8_SB(b, h) + boff + n * 2048 + k * 1024); } while (0)
#define PG8_MMA(ai, bj, At, Bt) do { __builtin_amdgcn_s_setprio(1); _Pragma("unroll") for (int m = 0; m < 4; ++m) _Pragma("unroll") for (int n = 0; n < 2; ++n) _Pragma("unroll") for (int k = 0; k < 2; ++k) \
        acc[ai][bj][m][n] = __builtin_amdgcn_mfma_f32_16x16x32_bf16(Bt[n][k], At[m][k], acc[ai][bj][m][n], 0, 0, 0); __builtin_amdgcn_s_setprio(0); } while (0)
#define PG8_WAIT_V(n) asm volatile("s_waitcnt vmcnt(" #n ")" ::: "memory")
#define PG8_WAIT_L(n) asm volatile("s_waitcnt lgkmcnt(" #n ")" ::: "memory")
#define PG8_BAR __builtin_amdgcn_s_barrier()
#define PG8_SCHED __builtin_amdgcn_sched_barrier(0)
#define PG8_APTR(u) ((const char*)g.A + ((size_t)(u).pm * BM * GEO::LDA + (size_t)((u).pn & ((1 << GEO::PNBITS) - 1)) * GEO::APN) * 2)
#define PG8_BPTR(u) ((const char*)g.Bt + ((size_t)((u).pn & ((1 << GEO::PNBITS) - 1)) * GEO::BPN + (size_t)((u).pn >> GEO::PNBITS) * GEO::BPNHI + (size_t)((u).pm >> GEO::BSHIFT) * GEO::BBATCH) * 2)
    Unit cur, nxt; int ui = 0;
    if (!S.next(0, cur)) return;
    Acc acc;
#pragma unroll
    for (int a = 0; a < 2; ++a)
#pragma unroll
        for (int b = 0; b < 2; ++b)
#pragma unroll
            for (int m = 0; m < 4; ++m)
#pragma unroll
                for (int n = 0; n < 2; ++n) acc[a][b][m][n] = (f32x4){0.f, 0.f, 0.f, 0.f};
    bf16x8 At[4][2], B0[2][2], B1[2][2];
    const char* cA = PG8_APTR(cur); const char* cB = PG8_BPTR(cur);
    PG8_STAGE(PG8_SB(0, 0), cB, voffB); PG8_STAGE(PG8_SB(0, 1), cB + hstepB, voffB); PG8_STAGE(PG8_SA(0, 0), cA, voffA); PG8_STAGE(PG8_SA(0, 1), cA + hstepA, voffA);
    if (wr == 1) PG8_BAR;
    PG8_WAIT_V(2); PG8_BAR;
    PG8_STAGE(PG8_SB(1, 0), cB + kstep, voffB); PG8_STAGE(PG8_SA(1, 0), cA + kstep, voffA); PG8_STAGE(PG8_SB(1, 1), cB + hstepB + kstep, voffB);
    PG8_WAIT_V(6); PG8_BAR;
    for (;;) {
        const bool has_next = S.next(ui + 1, nxt);
        const char* nA = has_next ? PG8_APTR(nxt) : cA; const char* nB = has_next ? PG8_BPTR(nxt) : cB;
#pragma nounroll
        for (int t = 0; t < nt; t += 2) {
            const bool last = (t == nt - 2);
            const char* a1 = cA + (size_t)(t + 1) * kstep;
            const char* a2 = last ? nA : cA + (size_t)(t + 2) * kstep; const char* b2 = last ? nB : cB + (size_t)(t + 2) * kstep;
            const char* a3 = a2 + kstep; const char* b3 = b2 + kstep;
            PG8_LDB(B0, 0, 0); PG8_LDB(B1, 0, 1); PG8_SCHED; PG8_LDA(At, 0, 0); PG8_STAGE(PG8_SA(1, 1), a1 + hstepA, voffA);
            PG8_WAIT_V(8); PG8_WAIT_L(0); PG8_BAR; PG8_MMA(0, 0, At, B0); PG8_MMA(0, 1, At, B1); PG8_BAR; PG8_SCHED;
            PG8_LDA(At, 0, 1); PG8_STAGE(PG8_SB(0, 0), b2, voffB); PG8_STAGE(PG8_SB(0, 1), b2 + hstepB, voffB); PG8_STAGE(PG8_SA(0, 0), a2, voffA);
            PG8_WAIT_V(8); PG8_WAIT_L(0); PG8_BAR; PG8_MMA(1, 0, At, B0); PG8_MMA(1, 1, At, B1); PG8_BAR; PG8_SCHED;
            PG8_LDB(B0, 1, 0); PG8_LDB(B1, 1, 1); PG8_SCHED; PG8_LDA(At, 1, 0); PG8_STAGE(PG8_SA(0, 1), a2 + hstepA, voffA);
            PG8_WAIT_V(8); PG8_WAIT_L(0); PG8_BAR; PG8_MMA(0, 0, At, B0); PG8_MMA(0, 1, At, B1); PG8_BAR; PG8_SCHED;
            PG8_LDA(At, 1, 1); PG8_STAGE(PG8_SB(1, 0), b3, voffB); PG8_STAGE(PG8_SB(1, 1), b3 + hstepB, voffB); PG8_STAGE(PG8_SA(1, 0), a3, voffA);
            PG8_WAIT_V(8); PG8_WAIT_L(0); PG8_BAR; PG8_MMA(1, 0, At, B0); PG8_MMA(1, 1, At, B1); PG8_BAR; PG8_SCHED;
        }
        if (wr == 0) PG8_BAR;
        E(acc, cur, wr, wc, fr, fq, lds);
        if (!has_next) break;
#pragma unroll
        for (int a = 0; a < 2; ++a)
#pragma unroll
            for (int b = 0; b < 2; ++b)
#pragma unroll
                for (int m = 0; m < 4; ++m)
#pragma unroll
                    for (int n = 0; n < 2; ++n) acc[a][b][m][n] = (f32x4){0.f, 0.f, 0.f, 0.f};
        cur = nxt; cA = nA; cB = nB; ++ui;
        if (wr == 1) PG8_BAR;
    }
    PG8_WAIT_V(0);
    PG8_BAR;
#undef PG8_SA
#undef PG8_SB
#undef PG8_STAGE
#undef PG8_LDA
#undef PG8_LDB
#undef PG8_MMA
#undef PG8_WAIT_V
#undef PG8_WAIT_L
#undef PG8_BAR
#undef PG8_SCHED
#undef PG8_APTR
#undef PG8_BPTR
}
}

constexpr size_t MiB = 1u << 20;
constexpr size_t WS_SUMSQ1 = 0, WS_SUMSQ2 = 1024 * 1024, WS_BAR = 512 * 1024;
constexpr size_t WS_WIN = 2 * MiB, WS_WOUT = 9 * MiB, WS_WQ = 11 * MiB, WS_WKV = 13 * MiB, WS_WO = 17 * MiB, WS_W1 = 19 * MiB, WS_W2 = 27 * MiB;
constexpr size_t WS_MEMN = 36 * MiB, WS_KN = 38 * MiB, WS_VT = 40 * MiB, WS_AUX = 42 * MiB;
constexpr size_t WS_CLOC = 46 * MiB, WS_CTOT = 47 * MiB, WS_DECAY = 47 * MiB + 65536;
constexpr size_t WS_XN = 48 * MiB, WS_DST = 48 * MiB, WS_U = 48 * MiB;
constexpr size_t WS_PROJ = 112 * MiB, WS_QN = 112 * MiB, WS_P = 176 * MiB;
constexpr size_t WS_VWT = 480 * MiB;
constexpr size_t WS_SPT = 320 * MiB, WS_MIX = 352 * MiB, WS_HB = 416 * MiB, WS_END = 488 * MiB;

struct Params {
    const float *x, *mem, *norm_mix_g, *w_in, *fox_b_f, *fox_q_g, *fox_k_g, *gla_w2, *gla_bg, *gla_og, *w_out, *norm_x_g, *norm_mem_g, *wq, *wkv, *xq_g, *xk_g, *wo, *norm_mlp_g, *w1, *w2;
    float* out; unsigned char* ws;
    long never;
};

DI float wave_sum(float v) {
#pragma unroll
    for (int o = 1; o < 64; o <<= 1) v += __shfl_xor(v, o);
    return v;
}
DI float logsig(float z) { return fminf(z, 0.f) - log1pf(expf(-fabsf(z))); }
DI float logsig_fast(float z) { return fminf(z, 0.f) - __logf(1.0f + __expf(-fabsf(z))); }

DI void p0_transpose_item(const float* W, int ldw, int src0, int K, bf16_t* WT, int dst0, const float* gain, LAS float* scr, int kb, int nb, int lane) {
    const int k0 = 64 * kb, n0 = 32 * nb, kr = lane >> 3, c4 = lane & 7;
    f32x4 v[8];
#pragma unroll
    for (int i = 0; i < 8; ++i) v[i] = __builtin_nontemporal_load((const f32x4*)(W + (size_t)(k0 + kr + 8 * i) * ldw + src0 + n0 + 4 * c4));
#pragma unroll
    for (int i = 0; i < 8; ++i) { const float g = gain ? gain[k0 + kr + 8 * i] : 1.0f; LAS float* d = scr + (kr + 8 * i) * 33 + 4 * c4; d[0] = v[i].x * g; d[1] = v[i].y * g; d[2] = v[i].z * g; d[3] = v[i].w * g; }
    asm volatile("s_waitcnt lgkmcnt(0)" ::: "memory");
    const int c = lane & 7;
#pragma unroll
    for (int j = 0; j < 4; ++j) { const int n = (lane >> 3) + 8 * j; const LAS float* s = scr + (8 * c) * 33 + n;
        u32x4 o; o.x = pk2(s[0 * 33], s[1 * 33]); o.y = pk2(s[2 * 33], s[3 * 33]); o.z = pk2(s[4 * 33], s[5 * 33]); o.w = pk2(s[6 * 33], s[7 * 33]);
        *(u32x4*)(WT + (size_t)(dst0 + n0 + n) * K + k0 + 8 * c) = o; }
    asm volatile("s_waitcnt lgkmcnt(0)" ::: "memory");
}
template <int NR> DI void rms_rows_load(f32x4 (&v)[NR][4], const float* xrow, int lane) {
#pragma unroll
    for (int r = 0; r < NR; ++r) { const f32x4* xr = (const f32x4*)(xrow + (size_t)r * DM) + lane;
#pragma unroll
        for (int j = 0; j < 4; ++j) v[r][j] = __builtin_nontemporal_load(xr + 64 * j); }
}
template <int NR> DI void rms_rows_store(const f32x4 (&v)[NR][4], const float* g, bf16_t* orow, int lane) {
    float s[NR];
#pragma unroll
    for (int r = 0; r < NR; ++r) { float a = 0.f;
#pragma unroll
        for (int j = 0; j < 4; ++j) a += (v[r][j].x * v[r][j].x + v[r][j].y * v[r][j].y) + (v[r][j].z * v[r][j].z + v[r][j].w * v[r][j].w);
        s[r] = a; }
#pragma unroll
    for (int o = 1; o < 64; o <<= 1)
#pragma unroll
        for (int r = 0; r < NR; ++r) s[r] += __shfl_xor(s[r], o);
    const f32x4* gr = (const f32x4*)g + lane;
#pragma unroll
    for (int j = 0; j < 4; ++j) { const f32x4 gg = gr[64 * j];
#pragma unroll
        for (int r = 0; r < NR; ++r) { const float rstd = rsqrtf(s[r] * (1.f / DM) + EPS); u32x2 w; w.x = pk2(v[r][j].x * rstd * gg.x, v[r][j].y * rstd * gg.y); w.y = pk2(v[r][j].z * rstd * gg.z, v[r][j].w * rstd * gg.w);
            ((u32x2*)(orow + (size_t)r * DM) + lane)[64 * j] = w; } }
}
DI void late_transposes(const Params& p, LAS unsigned char* lds, int gwv, int ngw) {
    const int tid = get_tid(), lane = tid & 63, wave = tid >> 6;
    unsigned char* ws = p.ws;
    LAS float* scr = (LAS float*)(lds + wave * 16384);
    constexpr int J3 = 16 * 32, J4 = 16 * 32, J6 = 16 * 32, J7 = 16 * 128, J8 = 64 * 32;
    for (int it = gwv; it < J3 + J4 + J6 + J7 + J8; it += ngw) {
        int r = it;
        if (r < J3) { p0_transpose_item(p.w_out, DM, 0, DM, (bf16_t*)(ws + WS_WOUT), 0, nullptr, scr, r / 32, r % 32, lane); continue; } r -= J3;
        if (r < J4) { p0_transpose_item(p.wq, DM, 0, DM, (bf16_t*)(ws + WS_WQ), 0, p.norm_x_g, scr, r / 32, r % 32, lane); continue; } r -= J4;
        if (r < J6) { p0_transpose_item(p.wo, DM, 0, DM, (bf16_t*)(ws + WS_WO), 0, nullptr, scr, r / 32, r % 32, lane); continue; } r -= J6;
        if (r < J7) { p0_transpose_item(p.w1, FF, 0, DM, (bf16_t*)(ws + WS_W1), 0, p.norm_mlp_g, scr, r / 128, r % 128, lane); continue; } r -= J7;
        p0_transpose_item(p.w2, DM, 0, FF, (bf16_t*)(ws + WS_W2), 0, nullptr, scr, r / 32, r % 32, lane);
    }
}
DI void p0_prologue(const Params& p, LAS unsigned char* lds, int G) {
    const int tid = get_tid(), lane = tid & 63, wave = tid >> 6;
    unsigned char* ws = p.ws;
    LAS float* scr = (LAS float*)(lds + wave * 16384);
    const int gw = blockIdx.x * 8 + wave, NGW = G * 8;
    constexpr int I0 = 16 * 48, I1 = 16 * 32, I2 = 16 * 16, I3 = 16 * 32, I4 = 16 * 32, I5 = 16 * 64, I6 = 16 * 32, I7 = 16 * 128, I8 = 64 * 32;
    constexpr int NITEMS = I0 + I1 + I2 + I3 + I4 + I5 + I6 + I7 + I8;
    const int wu = __builtin_amdgcn_readfirstlane(wave);
    for (int ph = 0; ph < 2; ++ph) {
    if (((ph ^ wu) & 1) == 1) {
    for (int r16 = 0; r16 < (PROBE_ID == 16 ? 2 : 1); ++r16) {
    for (int it = gw; it < I0 + I1 + I2 + I5; it += NGW) {
        int r = it;
        if (r < I0) { p0_transpose_item(p.w_in, 3096, 0, DM, (bf16_t*)(ws + WS_WIN), 0, nullptr, scr, r / 48, r % 48, lane); continue; } r -= I0;
        if (r < I1) { p0_transpose_item(p.w_in, 3096, 1544, DM, (bf16_t*)(ws + WS_WIN), 1536, nullptr, scr, r / 32, r % 32, lane); continue; } r -= I1;
        if (r < I2) { p0_transpose_item(p.w_in, 3096, 2584, DM, (bf16_t*)(ws + WS_WIN), 2560, nullptr, scr, r / 16, r % 16, lane); continue; } r -= I2;
        p0_transpose_item(p.wkv, 2 * DM, 0, DM, (bf16_t*)(ws + WS_WKV), 0, nullptr, scr, r / 64, r % 64, lane);
    }
    }
    } else {
    for (int r15 = 0; r15 < (PROBE_ID == 15 ? 2 : 1); ++r15)
    { f32x4 va[4][4], vb[4][4];
      int m = gw * 4;
      if (m < MTOK) rms_rows_load<4>(va, p.x + (size_t)m * DM, lane);
      for (; m < MTOK; m += NGW * 8) {
          const int m1 = m + NGW * 4, m2 = m + NGW * 8;
          if (m1 < MTOK) rms_rows_load<4>(vb, p.x + (size_t)m1 * DM, lane);
          rms_rows_store<4>(va, p.norm_mix_g, (bf16_t*)(ws + WS_XN) + (size_t)m * DM, lane);
          if (m2 < MTOK) rms_rows_load<4>(va, p.x + (size_t)m2 * DM, lane);
          if (m1 < MTOK) rms_rows_store<4>(vb, p.norm_mix_g, (bf16_t*)(ws + WS_XN) + (size_t)m1 * DM, lane);
      } }
    }
    }
    if (G != 256) late_transposes(p, lds, gw, NGW);
    { bf16_t* wt = (bf16_t*)(ws + WS_WIN) + (size_t)3072 * DM;
      for (int idx = blockIdx.x * 512 + tid; idx < 256 * DM; idx += G * 512) { const int r = idx >> 10, k = idx & 1023; float w = 0.f;
          if (r < 8) w = p.w_in[(size_t)k * 3096 + 1536 + r]; else if (r < 24) w = p.w_in[(size_t)k * 3096 + 2568 + (r - 8)];
          wt[idx] = f2bf(w); } }
    for (int m = gw; m < NBATCH * MEMLEN; m += NGW) { f32x4 v1[1][4]; rms_rows_load<1>(v1, p.mem + (size_t)m * DM, lane); rms_rows_store<1>(v1, p.norm_mem_g, (bf16_t*)(ws + WS_MEMN) + (size_t)m * DM, lane); }
}

constexpr int VT_PITCH = 72;
constexpr int L2_VT = 0, L2_KDT = 73728, L2_AUX = 110592, L2_DEC = 118784;
constexpr int VS_PITCH = 544;
DI void stage_vT(const bf16_t* proj, int tok0, LAS unsigned char* lds, int tid) {
    LAS bf16_t* vS = (LAS bf16_t*)(lds + L2_VT);
    u32x4 w[8];
#pragma unroll
    for (int i8 = 0; i8 < 8; ++i8) { const int piece = tid + 512 * i8, row = piece >> 6, cp = piece & 63; w[i8] = *(const u32x4*)(proj + (size_t)(tok0 + row) * NPROJ + C_GV + cp * 8); }
#pragma unroll
    for (int i8 = 0; i8 < 8; ++i8) { const int piece = tid + 512 * i8, row = piece >> 6, cp = piece & 63; *(LAS u32x4*)(vS + row * VS_PITCH + cp * 8) = w[i8]; }
}
template <int PITCH = VS_PITCH> DI bf16x8 vs_frag(const LAS bf16_t* vS, int row0, int rstep, int col0, int lane) {
    const LAS bf16_t* vp = vS + (row0 + ((lane & 15) >> 2)) * PITCH + col0 + 16 * ((lane >> 4) & 1) + 4 * (lane & 3);
    const s16x4 lo = __builtin_bit_cast(s16x4, __builtin_amdgcn_ds_read_tr16_b64_v4i16((LAS v4i16_t*)vp));
    const s16x4 hh = __builtin_bit_cast(s16x4, __builtin_amdgcn_ds_read_tr16_b64_v4i16((LAS v4i16_t*)(vp + rstep * PITCH)));
    return __builtin_shufflevector(lo, hh, 0, 1, 2, 3, 4, 5, 6, 7);
}
constexpr int KD_PITCH = 288;
DI void p2_unit(int chunk, const Params& p, LAS unsigned char* lds) {
    const int tid = get_tid(), lane = tid & 63, wid = __builtin_amdgcn_readfirstlane(tid >> 6), r32 = lane & 31, hi = lane >> 5;
    unsigned char* ws = p.ws;
    bf16_t* proj = (bf16_t*)(ws + WS_PROJ); const float* aux = (const float*)(ws + WS_AUX);
    const int b = chunk >> 7, n = chunk & 127, tok0 = chunk * 64;
    LAS bf16_t* vT = (LAS bf16_t*)(lds + L2_VT); LAS bf16_t* kdT = (LAS bf16_t*)(lds + L2_KDT); LAS float* auxs = (LAS float*)(lds + L2_AUX); LAS float* decs = (LAS float*)(lds + L2_DEC);
    stage_vT(proj, tok0, lds, tid);
    if (wid >= 4) { const int wj = wid - 4;
#pragma unroll
        for (int hh = 0; hh < 2; ++hh) { const int h = 2 * wj + hh;
            float v = logsig(aux[(size_t)(tok0 + lane) * 32 + h] + p.fox_b_f[h]) * LOG2E;
#pragma unroll
            for (int o = 1; o < 64; o <<= 1) { const float t = __shfl_up(v, o); if (lane >= o) v += t; }
            ((float*)(ws + WS_CLOC))[(size_t)(b * 8 + h) * SEQ + n * 64 + lane] = v;
            if (lane == 63) ((float*)(ws + WS_CTOT))[(b * 8 + h) * 128 + n] = v; } }
    { const int col = tid & 255, half = tid >> 8, t0 = 32 * half, t0u = __builtin_amdgcn_readfirstlane(t0);
      LAS float* tots = (LAS float*)(lds + L2_DEC) + 256;
      float w2c[16];
#pragma unroll
      for (int r = 0; r < 16; ++r) w2c[r] = p.gla_w2[r * 256 + col];
      const float bgc = p.gla_bg[col];
      bf16_t* pq = proj + (size_t)(tok0 + t0) * NPROJ + C_GQ + col; bf16_t* pk = proj + (size_t)(tok0 + t0) * NPROJ + C_GK + col;
      bf16_t qv32[32], kv32[32];
#pragma unroll
      for (int j2 = 0; j2 < 32; ++j2) { qv32[j2] = pq[(size_t)j2 * NPROJ]; kv32[j2] = pk[(size_t)j2 * NPROJ]; }
      float lc[32]; float bc = 0.f;
#pragma unroll
      for (int j2 = 0; j2 < 32; ++j2) { const f32x4* ar = (const f32x4*)(aux + (size_t)(tok0 + t0u + j2) * 32 + 8);
          float z = bgc;
#pragma unroll
          for (int r4 = 0; r4 < 4; ++r4) { const f32x4 a = ar[r4]; z += a.x * w2c[4 * r4] + a.y * w2c[4 * r4 + 1] + a.z * w2c[4 * r4 + 2] + a.w * w2c[4 * r4 + 3]; }
          bc += logsig_fast(z) * (1.0f / 16.0f); lc[j2] = bc; }
      if (half == 0) tots[col] = bc;
      __syncthreads();
      const float offs = half ? tots[col] : 0.f;
#pragma unroll
      for (int j2 = 0; j2 < 32; ++j2) { const float bcl = (offs + lc[j2]) * LOG2E;
          const float qd = bf2f(qv32[j2]) * 0.125f * __builtin_amdgcn_exp2f(bcl), kd = bf2f(kv32[j2]) * __builtin_amdgcn_exp2f(-bcl);
          const bf16_t kdb = f2bf(kd);
          pq[(size_t)j2 * NPROJ] = f2bf(qd); pk[(size_t)j2 * NPROJ] = kdb; kdT[(t0 + j2) * KD_PITCH + col] = kdb; }
      if (half) { const float dec = __builtin_amdgcn_exp2f((offs + bc) * LOG2E); decs[col] = dec; ((float*)(ws + WS_DECAY))[(size_t)(b * 128 + n) * 256 + col] = dec; }
    }
    __syncthreads();
    { const int h = wid >> 1, vb0 = (wid & 1) * 2, bh = b * 4 + h;
      f32x16 d[2][2];
#pragma unroll
      for (int i = 0; i < 2; ++i)
#pragma unroll
          for (int j = 0; j < 2; ++j)
#pragma unroll
              for (int e = 0; e < 16; ++e) d[i][j][e] = 0.f;
#pragma unroll
      for (int s = 0; s < 4; ++s) { bf16x8 a[2], bb[2];
#pragma unroll
          for (int i = 0; i < 2; ++i) a[i] = vs_frag(vT, 16 * s + 8 * hi, 4, h * 128 + 32 * (vb0 + i), lane);
#pragma unroll
          for (int j = 0; j < 2; ++j) bb[j] = vs_frag<KD_PITCH>(kdT, 16 * s + 8 * hi, 4, h * 64 + 32 * j, lane);
#pragma unroll
          for (int i = 0; i < 2; ++i)
#pragma unroll
              for (int j = 0; j < 2; ++j) d[i][j] = __builtin_amdgcn_mfma_f32_32x32x16_bf16(a[i], bb[j], d[i][j], 0, 0, 0); }
      float* dst = (float*)(ws + WS_DST) + ((size_t)bh * 128 + n) * 8192;
#pragma unroll
      for (int j = 0; j < 2; ++j) { const float dec = decs[h * 64 + 32 * j + r32];
#pragma unroll
          for (int i = 0; i < 2; ++i)
#pragma unroll
              for (int e = 0; e < 16; ++e) __builtin_nontemporal_store(d[i][j][e] * dec, dst + (32 * (vb0 + i) + crow(e, hi)) * 64 + 32 * j + r32); } }
    __syncthreads();
}

DI void gla_scan(const Params& p, int G, LAS unsigned char* lds) {
    const float* dST = (const float*)(p.ws + WS_DST); const float* decay = (const float*)(p.ws + WS_DECAY); bf16_t* SpT = (bf16_t*)(p.ws + WS_SPT);
    LAS float* dl = (LAS float*)lds;
    const int tid = get_tid();
    for (int e0 = blockIdx.x * 512; e0 < 16 * 8192; e0 += G * 512) {
        const int e = e0 + tid, bh = e0 >> 13, vk = e & 8191, k = e & 63, b = bh >> 2, h = bh & 3;
        __syncthreads();
#pragma unroll
        for (int i4 = 0; i4 < 4; ++i4) { const int idx = tid * 4 + 2048 * i4, n = idx >> 6, kk = idx & 63;
            *(LAS f32x4*)(dl + idx) = *(const f32x4*)(decay + (size_t)(b * 128 + n) * 256 + h * 64 + kk); }
        __syncthreads();
        const float* dp = dST + (size_t)bh * 128 * 8192 + vk; bf16_t* sp = SpT + (size_t)bh * 128 * 8192 + vk;
        float st = 0.f;
        for (int n0 = 0; n0 < 128; n0 += 64) { float dv[64];
#pragma unroll
            for (int j2 = 0; j2 < 64; ++j2) dv[j2] = __builtin_nontemporal_load(dp + (size_t)(n0 + j2) * 8192);
#pragma unroll
            for (int j2 = 0; j2 < 64; ++j2) { sp[(size_t)(n0 + j2) * 8192] = f2bf(st); st = dl[(n0 + j2) * 64 + k] * st + dv[j2]; } }
    }
    __syncthreads();
}

constexpr int FX_K = 0, FX_V = 36864, FX_CK = 73728, FX_CB = 74752, FX_AL = 75264, FX_TLO = 76288, FX_KP = 72;
DI void fx_init(f32x16& p0, f32x16& p1, const LAS float* ck, float cqm, int hi) {
#pragma unroll
    for (int g = 0; g < 4; ++g) { const f32x4 c0 = *(const LAS f32x4*)(ck + 8 * g + 4 * hi), c1 = *(const LAS f32x4*)(ck + 32 + 8 * g + 4 * hi);
#pragma unroll
        for (int e = 0; e < 4; ++e) { p0[4 * g + e] = cqm - c0[e]; p1[4 * g + e] = cqm - c1[e]; } }
}
DI void fx_qk(f32x16& p0, f32x16& p1, const LAS bf16_t* Kt, const bf16x8 (&qr)[4], int r32, int hi) {
#pragma unroll
    for (int ks = 0; ks < 4; ++ks) { const bf16x8 a0 = *(const LAS bf16x8*)(Kt + r32 * 72 + 16 * ks + 8 * hi), a1 = *(const LAS bf16x8*)(Kt + (32 + r32) * 72 + 16 * ks + 8 * hi);
        p0 = __builtin_amdgcn_mfma_f32_32x32x16_bf16(a0, qr[ks], p0, 0, 0, 0); p1 = __builtin_amdgcn_mfma_f32_32x32x16_bf16(a1, qr[ks], p1, 0, 0, 0); }
}
DI void fx_vfrag(bf16x8 (&vfr)[4][2], const LAS bf16_t* Vt, int lane, int hi) {
#pragma unroll
    for (int st = 0; st < 4; ++st)
#pragma unroll
        for (int db = 0; db < 2; ++db) { const LAS bf16_t* vp = Vt + (16 * st + 4 * hi + ((lane & 15) >> 2)) * 72 + 32 * db + 16 * ((lane >> 4) & 1) + 4 * (lane & 3);
            const s16x4 lo = __builtin_bit_cast(s16x4, __builtin_amdgcn_ds_read_tr16_b64_v4i16((LAS v4i16_t*)vp));
            const s16x4 hh = __builtin_bit_cast(s16x4, __builtin_amdgcn_ds_read_tr16_b64_v4i16((LAS v4i16_t*)(vp + 8 * 72)));
            vfr[st][db] = __builtin_shufflevector(lo, hh, 0, 1, 2, 3, 4, 5, 6, 7); }
}
template <bool PEND> DI void fx_softmax(f32x16& p0, f32x16& p1, f32x16& q0, f32x16& q1, bf16x8 (&pw)[4], f32x16 (&o)[2], float& m, float& l, float& cqm, float cq, LAS float* al,
                                        int k0, int qw0, int qrow, int r32, int hi) {
    if (k0 + 63 > qw0) {
#pragma unroll
        for (int i = 0; i < 16; ++i) { const int kv = k0 + crow(i, hi); if (kv > qrow) p0[i] = -INFINITY; if (kv + 32 > qrow) p1[i] = -INFINITY; } }
    float rm = fmaxf(fmaxf(p0[0], p1[0]), fmaxf(p0[1], p1[1]));
#pragma unroll
    for (int i = 2; i < 16; i += 2) { rm = fmaxf(fmaxf(rm, p0[i]), p1[i]); rm = fmaxf(fmaxf(rm, p0[i + 1]), p1[i + 1]); }
    rm = fmaxf(rm, __shfl_xor(rm, 32));
    if (__any(rm > 0.f)) {
        const float dl = fmaxf(rm, 0.f), alpha = __builtin_amdgcn_exp2f(-dl); l *= alpha; m += dl; cqm = cq - m;
#pragma unroll
        for (int i = 0; i < 16; ++i) { p0[i] -= dl; p1[i] -= dl; }
        if (PEND) {
#pragma unroll
            for (int i = 0; i < 16; ++i) { q0[i] -= dl; q1[i] -= dl; } }
        if (hi == 0) al[r32] = alpha;
        asm volatile("s_waitcnt lgkmcnt(0)" ::: "memory");
#pragma unroll
        for (int g = 0; g < 4; ++g) { const f32x4 a4 = *(const LAS f32x4*)(al + 8 * g + 4 * hi);
#pragma unroll
            for (int e = 0; e < 4; ++e) { o[0][4 * g + e] *= a4[e]; o[1][4 * g + e] *= a4[e]; } }
        asm volatile("" ::: "memory");
    }
#pragma unroll
    for (int i = 0; i < 16; ++i) { p0[i] = __builtin_amdgcn_exp2f(p0[i]); p1[i] = __builtin_amdgcn_exp2f(p1[i]); }
    { const f32x16 t = p0 + p1; const f32x4 u4 = (f32x4){t[0], t[1], t[2], t[3]} + (f32x4){t[4], t[5], t[6], t[7]} + (f32x4){t[8], t[9], t[10], t[11]} + (f32x4){t[12], t[13], t[14], t[15]};
      l += (u4.x + u4.y) + (u4.z + u4.w); }
#pragma unroll
    for (int s2 = 0; s2 < 2; ++s2) { u32x4 w0, w1;
#pragma unroll
        for (int e = 0; e < 4; ++e) { w0[e] = pk2(p0[8 * s2 + 2 * e], p0[8 * s2 + 2 * e + 1]); w1[e] = pk2(p1[8 * s2 + 2 * e], p1[8 * s2 + 2 * e + 1]); }
        pw[s2] = __builtin_bit_cast(bf16x8, w0); pw[2 + s2] = __builtin_bit_cast(bf16x8, w1); }
}
DI void fx_pv(f32x16 (&o)[2], const bf16x8 (&pw)[4], const bf16x8 (&vfr)[4][2]) {
#pragma unroll
    for (int st = 0; st < 4; ++st)
#pragma unroll
        for (int db = 0; db < 2; ++db) o[db] = __builtin_amdgcn_mfma_f32_32x32x16_bf16(pw[st], vfr[st][db], o[db], 0, 0, 0);
}
DI void fox_bh_setup(int bh, const Params& p, LAS unsigned char* lds) {
    const int tid = get_tid(), lane = tid & 63, wid = tid >> 6;
    LAS float* cbase = (LAS float*)(lds + FX_CB);
    const float* ct = (const float*)(p.ws + WS_CTOT) + bh * 128;
    __syncthreads();
    if (wid == 0) { const float v0 = ct[2 * lane], v1 = ct[2 * lane + 1], s = v0 + v1; float incl = s;
#pragma unroll
        for (int o = 1; o < 64; o <<= 1) { const float t = __shfl_up(incl, o); if (lane >= o) incl += t; }
        const float excl = incl - s; cbase[2 * lane] = excl; cbase[2 * lane + 1] = excl + v0; }
    __syncthreads();
}
DI void fox_unit(int bh, int qb, const Params& p, LAS unsigned char* lds, float thr2) {
    const int tid = get_tid(), lane = tid & 63, wid = __builtin_amdgcn_readfirstlane(tid >> 6), r32 = lane & 31, hi = lane >> 5;
    const bf16_t* proj = (const bf16_t*)(p.ws + WS_PROJ);
    const int b = bh >> 3, h = bh & 7, q0 = qb * 256; const size_t rowbase = (size_t)b * SEQ;
    LAS bf16_t* Kb = (LAS bf16_t*)(lds + FX_K); LAS bf16_t* Vb = (LAS bf16_t*)(lds + FX_V); LAS float* ckb = (LAS float*)(lds + FX_CK); LAS float* cbase = (LAS float*)(lds + FX_CB);
    LAS float* al = (LAS float*)(lds + FX_AL) + wid * 32; LAS int* tlo = (LAS int*)(lds + FX_TLO);
    const float* cl = (const float*)(p.ws + WS_CLOC) + (size_t)bh * SEQ;
#define FX_C2(t) (cbase[(t) >> 6] + cl[(t)])
    const int T_hi = q0 / 128 + 1;
    const int krow = tid & 127, chunk = tid >> 7;
    u32x4 kreg[2], vreg[2]; float ckreg = 0.f;
#define FX_LOAD(T) do { const bf16_t* rp = proj + (rowbase + 128 * (T) + krow) * NPROJ + h * 64 + chunk * 8; \
        kreg[0] = *(const u32x4*)(rp + C_FK); kreg[1] = *(const u32x4*)(rp + C_FK + 32); vreg[0] = *(const u32x4*)(rp + C_FV); vreg[1] = *(const u32x4*)(rp + C_FV + 32); \
        if (tid < 128) ckreg = FX_C2(128 * (T) + tid); } while (0)
#define FX_STORE(buf) do { _Pragma("unroll") for (int i_ = 0; i_ < 2; ++i_) { *(LAS u32x4*)(Kb + (buf) * 9216 + krow * FX_KP + (chunk + 4 * i_) * 8) = kreg[i_]; \
            *(LAS u32x4*)(Vb + (buf) * 9216 + krow * FX_KP + (chunk + 4 * i_) * 8) = vreg[i_]; } \
        if (tid < 128) ckb[(buf) * 128 + tid] = ckreg; } while (0)
    FX_LOAD(T_hi);
    const int qw0 = q0 + 32 * wid, qrow = qw0 + r32;
    bf16x8 qr[4];
#pragma unroll
    for (int ks = 0; ks < 4; ++ks) qr[ks] = *(const bf16x8*)(proj + (rowbase + qrow) * NPROJ + C_FQ + h * 64 + 16 * ks + 8 * hi);
    if (tid == 0) *tlo = q0 / 64;
    const float cq0 = FX_C2(q0), cq = FX_C2(qrow);
    const float cend = (tid < q0 / 64) ? FX_C2(64 * tid + 63) : 0.f;
    __syncthreads();
    if (tid < q0 / 64) { if (cq0 - cend >= -thr2) atomicMin((int*)tlo, tid); }
    FX_STORE(0);
    __syncthreads();
    const int t_lo = *tlo, T_lo = t_lo >> 1;
    float m = 0.f, l = 0.f, cqm = cq; f32x16 o[2];
#pragma unroll
    for (int e = 0; e < 16; ++e) { o[0][e] = 0.f; o[1][e] = 0.f; }
    for (int T = T_hi; T >= T_lo; --T) {
        const int buf = (T_hi - T) & 1;
        if (T > T_lo) FX_LOAD(T - 1);
        { const int k1 = 128 * T + 64, k0s = 128 * T;
          const LAS float* ckT = ckb + buf * 128; const LAS bf16_t* KtT = Kb + buf * 9216; const LAS bf16_t* VtT = Vb + buf * 9216;
          const bool act1 = (k1 <= qw0 + 31) && (2 * T + 1 >= t_lo), act0 = (k0s <= qw0 + 31) && (2 * T >= t_lo);
          if (act1 && act0) {
              f32x16 a0, a1, b0, b1; bf16x8 vfr[4][2], pw[4];
              fx_init(a0, a1, ckT + 64, cqm, hi); fx_init(b0, b1, ckT, cqm, hi);
              fx_qk(a0, a1, KtT + 64 * FX_KP, qr, r32, hi);
              fx_qk(b0, b1, KtT, qr, r32, hi);
              fx_vfrag(vfr, VtT + 64 * FX_KP, lane, hi);
              __builtin_amdgcn_sched_barrier(0);
              fx_softmax<true>(a0, a1, b0, b1, pw, o, m, l, cqm, cq, al, k1, qw0, qrow, r32, hi);
              __builtin_amdgcn_sched_barrier(0);
              fx_pv(o, pw, vfr);
              fx_vfrag(vfr, VtT, lane, hi);
              __builtin_amdgcn_sched_barrier(0);
              fx_softmax<false>(b0, b1, b0, b1, pw, o, m, l, cqm, cq, al, k0s, qw0, qrow, r32, hi);
              __builtin_amdgcn_sched_barrier(0);
              fx_pv(o, pw, vfr);
          } else if (act1 || act0) {
              const int sub = act1 ? 1 : 0, k0 = 128 * T + 64 * sub;
              f32x16 p0, p1; bf16x8 vfr[4][2], pw[4];
              fx_init(p0, p1, ckT + 64 * sub, cqm, hi);
              fx_qk(p0, p1, KtT + (64 * sub) * FX_KP, qr, r32, hi);
              fx_vfrag(vfr, VtT + (64 * sub) * FX_KP, lane, hi);
              __builtin_amdgcn_sched_barrier(0);
              fx_softmax<false>(p0, p1, p0, p1, pw, o, m, l, cqm, cq, al, k0, qw0, qrow, r32, hi);
              __builtin_amdgcn_sched_barrier(0);
              fx_pv(o, pw, vfr);
          }
        }
        if (T > T_lo) FX_STORE(buf ^ 1);
        __syncthreads();
    }
    l += __shfl_xor(l, 32);
    if (hi == 0) al[r32] = 1.0f / l;
    asm volatile("s_waitcnt lgkmcnt(0)" ::: "memory");
    bf16_t* mix = (bf16_t*)(p.ws + WS_MIX);
#pragma unroll
    for (int g = 0; g < 4; ++g) { const f32x4 a4 = *(const LAS f32x4*)(al + 8 * g + 4 * hi);
#pragma unroll
        for (int e = 0; e < 4; ++e) { const int i = 4 * g + e; bf16_t* orow = mix + (rowbase + qw0 + crow(i, hi)) * DM + h * 64 + r32;
            orow[0] = f2bf(o[0][i] * a4[e]); orow[32] = f2bf(o[1][i] * a4[e]); } }
#undef FX_C2
#undef FX_LOAD
#undef FX_STORE
}

DI void gla_out_unit(int chunk, const Params& p, LAS unsigned char* lds) {
    const int tid = get_tid(), lane = tid & 63, wid = __builtin_amdgcn_readfirstlane(tid >> 6), r32 = lane & 31, hi = lane >> 5;
    const bf16_t* proj = (const bf16_t*)(p.ws + WS_PROJ);
    const int b = chunk >> 7, n = chunk & 127, tok0 = chunk * 64;
    LAS bf16_t* vT = (LAS bf16_t*)(lds + L2_VT);
    const int h = wid >> 1, cb = wid & 1, bh = b * 4 + h, tok = tok0 + 32 * cb + r32;
    bf16x8 qf[4], kf[2][4], sf[4][4];
#pragma unroll
    for (int ks = 0; ks < 4; ++ks) qf[ks] = *(const bf16x8*)(proj + (size_t)tok * NPROJ + C_GQ + h * 64 + 16 * ks + 8 * hi);
#pragma unroll
    for (int sb = 0; sb < 2; ++sb)
#pragma unroll
        for (int ks = 0; ks < 4; ++ks) kf[sb][ks] = *(const bf16x8*)(proj + (size_t)(tok0 + 32 * sb + r32) * NPROJ + C_GK + h * 64 + 16 * ks + 8 * hi);
    const bf16_t* sp = (const bf16_t*)(p.ws + WS_SPT) + ((size_t)bh * 128 + n) * 8192;
#pragma unroll
    for (int vb = 0; vb < 4; ++vb)
#pragma unroll
        for (int ks = 0; ks < 4; ++ks) sf[vb][ks] = *(const bf16x8*)(sp + (32 * vb + r32) * 64 + 16 * ks + 8 * hi);
    u32x2 gwv[4][4];
#pragma unroll
    for (int vb = 0; vb < 4; ++vb)
#pragma unroll
        for (int g = 0; g < 4; ++g) gwv[vb][g] = *(const u32x2*)(proj + (size_t)tok * NPROJ + C_GR + h * 128 + 32 * vb + 8 * g + 4 * hi);
    stage_vT(proj, tok0, lds, tid);
    __syncthreads();
    f32x16 oT[4];
#pragma unroll
    for (int vb = 0; vb < 4; ++vb)
#pragma unroll
        for (int e = 0; e < 16; ++e) oT[vb][e] = 0.f;
#pragma unroll
    for (int vb = 0; vb < 4; ++vb)
#pragma unroll
        for (int ks = 0; ks < 4; ++ks) oT[vb] = __builtin_amdgcn_mfma_f32_32x32x16_bf16(sf[vb][ks], qf[ks], oT[vb], 0, 0, 0);
#pragma unroll
    for (int sb = 0; sb < 2; ++sb) {
        if (sb <= cb) {
        f32x16 X;
#pragma unroll
        for (int e = 0; e < 16; ++e) X[e] = 0.f;
#pragma unroll
        for (int ks = 0; ks < 4; ++ks) X = __builtin_amdgcn_mfma_f32_32x32x16_bf16(kf[sb][ks], qf[ks], X, 0, 0, 0);
        if (sb == cb) {
#pragma unroll
            for (int i = 0; i < 16; ++i) if (crow(i, hi) > r32) X[i] = 0.f; }
        bf16x8 xs[2];
#pragma unroll
        for (int s2 = 0; s2 < 2; ++s2) { u32x4 w;
#pragma unroll
            for (int e = 0; e < 4; ++e) w[e] = pk2(X[8 * s2 + 2 * e], X[8 * s2 + 2 * e + 1]);
            xs[s2] = __builtin_bit_cast(bf16x8, w); }
#pragma unroll
        for (int vb = 0; vb < 4; ++vb)
#pragma unroll
            for (int st = 0; st < 2; ++st) { const bf16x8 af = vs_frag(vT, 32 * sb + 16 * st + 4 * hi, 8, h * 128 + 32 * vb, lane);
                oT[vb] = __builtin_amdgcn_mfma_f32_32x32x16_bf16(af, xs[st], oT[vb], 0, 0, 0); }
        }
    }
    float ss = 0.f;
#pragma unroll
    for (int vb = 0; vb < 4; ++vb)
#pragma unroll
        for (int e = 0; e < 16; ++e) ss += oT[vb][e] * oT[vb][e];
    ss += __shfl_xor(ss, 32);
    const float rstd = rsqrtf(ss * (1.0f / 128.0f) + EPS);
    bf16_t* mix = (bf16_t*)(p.ws + WS_MIX);
#pragma unroll
    for (int vb = 0; vb < 4; ++vb)
#pragma unroll
        for (int g = 0; g < 4; ++g) { const int v0 = 32 * vb + 8 * g + 4 * hi;
            const u32x2 gw = gwv[vb][g];
            const f32x4 gn = *(const f32x4*)(p.gla_og + h * 128 + v0);
            float r[4] = {bflo(gw.x), bfhi(gw.x), bflo(gw.y), bfhi(gw.y)}; float ov[4];
#pragma unroll
            for (int e = 0; e < 4; ++e) { const float sg = r[e] / (1.0f + __expf(-r[e])); ov[e] = oT[vb][4 * g + e] * rstd * gn[e] * sg; }
            u32x2 w; w.x = pk2(ov[0], ov[1]); w.y = pk2(ov[2], ov[3]);
            *(u32x2*)(mix + (size_t)tok * DM + 512 + h * 128 + v0) = w; }
    __syncthreads();
}

#define XB_TMO      128
#define XB_XCNT(j)  (256  + 64 * (j))
#define XB_XSUB(j)  (1280 + 64 * (j))
#define XB_XGEN(j)  (2304 + 64 * (j))
#define XB_TOP      3328
#define XB_TOPGEN   3392
#define XCD_BAR_WORDS 3456
#define XB_SPIN_CAP (1u << 18)
DI unsigned xb_ld(unsigned* p)              { return __hip_atomic_load(p, __ATOMIC_RELAXED, __HIP_MEMORY_SCOPE_AGENT); }
DI unsigned xb_add(unsigned* p, unsigned v) { return __hip_atomic_fetch_add(p, v, __ATOMIC_RELAXED, __HIP_MEMORY_SCOPE_AGENT); }
DI unsigned xb_xcc_id() { return (unsigned)__builtin_amdgcn_s_getreg((3 << 11) | 20) & 0xFu; }
#define XB_SPIN(cond, bar) do { unsigned _sp = 0; while (cond) { __builtin_amdgcn_s_sleep(1); \
    if ((++_sp & 255u) == 0u) { if (xb_ld(&(bar)[XB_TMO])) break; if (_sp > XB_SPIN_CAP) { atomicAdd(&(bar)[XB_TMO], 1u); break; } } } } while (0)
struct XcdBarrier { unsigned* bar; unsigned x; volatile LAS unsigned* st; };
DI XcdBarrier xcd_barrier_post(unsigned* bar, volatile LAS unsigned* st) {
    XcdBarrier b; b.bar = bar; b.x = xb_xcc_id(); b.st = st;
    if (threadIdx.x == 0) (void)xb_add(&bar[XB_XCNT(b.x)], 1u);
    return b;
}
DI void xcd_barrier_complete(unsigned* bar, unsigned x, unsigned& nloc, unsigned& nx) {
    const unsigned G = gridDim.x * gridDim.y * gridDim.z;
    unsigned sum, cnt, mine, sp = 0u;
    for (;;) {
        sum = 0u; cnt = 0u; mine = 0u;
#pragma unroll
        for (unsigned j = 0; j < 16; ++j) { const unsigned c = xb_ld(&bar[XB_XCNT(j)]); sum += c; cnt += (c > 0u) ? 1u : 0u; mine = (j == x) ? c : mine; }
        if (sum == G) break;
        __builtin_amdgcn_s_sleep(1);
        if ((++sp & 255u) == 0u) { if (xb_ld(&bar[XB_TMO])) break; if (sp > XB_SPIN_CAP) { atomicAdd(&bar[XB_TMO], 1u); break; } }
    }
    nloc = mine > 0u ? mine : 1u; nx = cnt > 0u ? cnt : 1u;
}
DI void xcd_barrier(const XcdBarrier& b) {
    asm volatile("s_waitcnt vmcnt(0)" ::: "memory");
    __syncthreads();
    if (threadIdx.x == 0) {
        unsigned* bar = b.bar;
        __builtin_amdgcn_s_waitcnt(0);
        unsigned nloc = b.st[0], nx = b.st[1];
        if (nloc == 0u) { xcd_barrier_complete(bar, b.x, nloc, nx); b.st[0] = nloc; b.st[1] = nx; }
        const unsigned old = xb_add(&bar[XB_XSUB(b.x)], 1u);
        const unsigned gen = old / nloc;
        if (old + 1u == (gen + 1u) * nloc) {
            __builtin_amdgcn_fence(__ATOMIC_RELEASE, "agent");
            asm volatile("s_waitcnt vmcnt(0)" ::: "memory");
            const unsigned og = xb_add(&bar[XB_TOP], 1u);
            const unsigned tg = og / nx;
            if (og + 1u == (tg + 1u) * nx) xb_add(&bar[XB_TOPGEN], 1u);
            else XB_SPIN(xb_ld(&bar[XB_TOPGEN]) == tg, bar);
            __builtin_amdgcn_fence(__ATOMIC_ACQUIRE, "agent");
            xb_add(&bar[XB_XGEN(b.x)], 1u);
            asm volatile("s_waitcnt vmcnt(0)" ::: "memory");
        } else {
            XB_SPIN(xb_ld(&bar[XB_XGEN(b.x)]) == gen, bar);
            __builtin_amdgcn_fence(__ATOMIC_ACQUIRE, "agent");
            asm volatile("s_waitcnt vmcnt(0)" ::: "memory");
        }
    }
    __syncthreads();
}

__global__ void __launch_bounds__(512, 2) fwd_megakernel(Params p) {
    extern __shared__ __attribute__((aligned(16))) unsigned char lds_raw[];
    LAS unsigned char* lds = (LAS unsigned char*)lds_raw;
    cg::grid_group grid = cg::this_grid();
    const int G = gridDim.x, bx = blockIdx.x;
    unsigned char* ws = p.ws;
    bf16_t* proj = (bf16_t*)(ws + WS_PROJ);

    if (threadIdx.x < 2) ((volatile LAS unsigned*)(lds + MISC_OFF))[threadIdx.x] = 0u;
    __syncthreads();
    if (p.never) grid.sync();
    const XcdBarrier xbar = xcd_barrier_post((unsigned*)(ws + WS_BAR), (volatile LAS unsigned*)(lds + MISC_OFF));
#define GSYNC() xcd_barrier(xbar)
    for (int rep = 0; rep < (PROBE_ID == 3 ? 2 : 1); ++rep) { p0_prologue(p, lds, G); if (PROBE_ID == 3) GSYNC(); }
    GSYNC();
    if (PROBE_ID == 1) { for (int rep = 0; rep < 10; ++rep) GSYNC(); }
    for (int rep10 = 0; rep10 < (PROBE_ID == 10 ? 2 : 1); ++rep10) {
    for (int rep = 0; rep < (PROBE_ID == 2 ? 2 : 1); ++rep) {
    { pg8::Gemm g{(const bf16_t*)(ws + WS_XN), (const bf16_t*)(ws + WS_WIN)};
      pg8::StaticOrder S; S.init(MTOK, NPROJ, G, bx);
      pg8::EpiProj E{proj, (float*)(ws + WS_AUX), p.fox_q_g, p.fox_k_g};
      pg8::gemm_phase<pg8::GeoPlain<DM>>(lds, g, S, E); }
    { pg8::Gemm g{(const bf16_t*)(ws + WS_MEMN), (const bf16_t*)(ws + WS_WKV)};
      pg8::StaticOrder S; S.init(NBATCH * MEMLEN, 2 * DM, G, (bx + G / 2) % G);
      pg8::EpiNorm E{(bf16_t*)(ws + WS_KN), nullptr, p.xk_g, 1.0f, (bf16_t*)(ws + WS_VT)};
      pg8::gemm_phase<pg8::GeoPlain<DM>>(lds, g, S, E); }
    if (G == 256 && bx >= 160) { __syncthreads(); late_transposes(p, lds, (bx - 160) * 8 + (int)(threadIdx.x >> 6), (G - 160) * 8); }
    if (PROBE_ID == 2 && rep == 0) GSYNC(); }
    GSYNC();
    for (int c = bx; c < MTOK / 64; c += G) p2_unit(c, p, lds);
    GSYNC();
    }
    for (int rep = 0; rep < (PROBE_ID == 4 ? 2 : 1); ++rep) {
    { pg8::Gemm g{(const bf16_t*)(ws + WS_WO), (const bf16_t*)(ws + WS_VT)};
      pg8::StaticOrder S; S.init(DM, 4 * DM, G, (G == 256) ? ((((bx >> 3) & 7) <= 1) ? ((bx & 7) + 8 * ((bx >> 3) & 7) + 16 * (bx >> 6)) : 64 + bx) : bx);
      pg8::EpiBf<4 * DM, 0, false, -1> E{(bf16_t*)(ws + WS_VWT), nullptr, nullptr};
      pg8::gemm_phase<pg8::Geo<256, DM, DM, 256, 256, 0, 0, 2, 256L * DM>>(lds, g, S, E); }
    for (int r11 = 0; r11 < (PROBE_ID == 11 ? 2 : 1); ++r11) gla_scan(p, G, lds);
    { const int tl = get_tid() & 63; float gq = fabsf(p.fox_q_g[tl]), gk = fabsf(p.fox_k_g[tl]);
#pragma unroll
      for (int o = 1; o < 64; o <<= 1) { gq = fmaxf(gq, __shfl_xor(gq, o)); gk = fmaxf(gk, __shfl_xor(gk, o)); }
      const float bqk = 64.0f * gq * gk * 0.125f * LOG2E * 1.02f, thr2 = 150.0f + bqk;
      if (G == 256) { const int bh = (bx & 7) * 4 + (bx >> 6), j = (bx >> 3) & 7;
          fox_bh_setup(bh, p, lds);
          for (int i = 3; i >= 0; --i) fox_unit(bh, j + 8 * i, p, lds, thr2); }
      else { for (int u = bx; u < 1024; u += G) { fox_bh_setup(u >> 5, p, lds); fox_unit(u >> 5, u & 31, p, lds, thr2); } } }
    if (PROBE_ID == 4 && rep == 0) GSYNC(); }
    GSYNC();
    for (int rep = 0; rep < (PROBE_ID == 5 ? 2 : 1); ++rep) {
    for (int c = bx; c < MTOK / 64; c += G) gla_out_unit(c, p, lds);
    if (PROBE_ID == 5 && rep == 0) GSYNC(); }
    GSYNC();
    { pg8::Gemm g{(const bf16_t*)(ws + WS_MIX), (const bf16_t*)(ws + WS_WOUT)};
      pg8::StaticOrder S; S.init(MTOK, DM, G, bx);
      pg8::EpiRes<false, false, true> E{p.x, nullptr, (bf16_t*)(ws + WS_HB), (float*)(ws + WS_SUMSQ1)};
      pg8::gemm_phase<pg8::GeoPlain<DM>>(lds, g, S, E); }
    GSYNC();
    for (int rep = 0; rep < (PROBE_ID == 6 ? 2 : 1); ++rep) {
    { pg8::Gemm g{(const bf16_t*)(ws + WS_HB), (const bf16_t*)(ws + WS_WQ)};
      pg8::StaticOrder S; S.init(MTOK, DM, G, bx);
      pg8::EpiNorm E{(bf16_t*)(ws + WS_QN), (const float*)(ws + WS_SUMSQ1), p.xq_g, 1.0f / 16.0f, nullptr};
      pg8::gemm_phase<pg8::GeoPlain<DM>>(lds, g, S, E); }
    if (PROBE_ID == 6 && rep == 0) GSYNC(); }
    GSYNC();
    for (int rep = 0; rep < (PROBE_ID == 7 ? 2 : 1); ++rep) {
    { pg8::Gemm g{(const bf16_t*)(ws + WS_QN), (const bf16_t*)(ws + WS_KN)};
      pg8::StaticOrder S; S.init(MTOK, DM, G, bx);
      pg8::EpiSoftmax E{(bf16_t*)(ws + WS_P)};
      pg8::gemm_phase<pg8::Geo<256, DM, DM, 256, 256, 256L * DM, 5>>(lds, g, S, E); }
    if (PROBE_ID == 7 && rep == 0) GSYNC(); }
    GSYNC();
    { pg8::Gemm g{(const bf16_t*)(ws + WS_P), (const bf16_t*)(ws + WS_VWT)};
      pg8::StaticOrder S; S.init(MTOK, DM, G, bx);
      pg8::EpiRes<true, false, true> E{(const void*)(ws + WS_HB), nullptr, (bf16_t*)(ws + WS_HB), (float*)(ws + WS_SUMSQ2)};
      pg8::gemm_phase<pg8::Geo<DM, DM, 4 * DM, 0, 256L * 4 * DM, DM, 5>>(lds, g, S, E); }
    GSYNC();
    for (int rep = 0; rep < (PROBE_ID == 9 ? 2 : 1); ++rep) {
    { pg8::Gemm g{(const bf16_t*)(ws + WS_HB), (const bf16_t*)(ws + WS_W1)};
      pg8::StaticOrder S; S.init(MTOK, FF, G, bx);
      pg8::EpiBf<FF, 1, true, -1> E{(bf16_t*)(ws + WS_U), (const float*)(ws + WS_SUMSQ2), nullptr};
      pg8::gemm_phase<pg8::GeoPlain<DM>>(lds, g, S, E); }
    if (PROBE_ID == 9 && rep == 0) GSYNC(); }
    GSYNC();
    { pg8::Gemm g{(const bf16_t*)(ws + WS_U), (const bf16_t*)(ws + WS_W2)};
      pg8::StaticOrder S; S.init(MTOK, DM, G, bx);
      pg8::EpiRes<true, true, false> E{(const void*)(ws + WS_HB), p.out, nullptr, nullptr};
      pg8::gemm_phase<pg8::GeoPlain<FF>>(lds, g, S, E); }
}

extern "C" void kernel_launch(void* const* d_in, const int* in_sizes, int n_in, void* d_out, int out_size, void* d_ws, size_t ws_size, hipStream_t stream) {
    static int grid = 0;
    if (grid == 0) {
        int dev = 0, cus = 0, per_cu = 0;
        hipGetDevice(&dev);
        hipDeviceGetAttribute(&cus, hipDeviceAttributeMultiprocessorCount, dev);
        hipFuncSetAttribute((const void*)fwd_megakernel, hipFuncAttributeMaxDynamicSharedMemorySize, LDS_BYTES);
        hipOccupancyMaxActiveBlocksPerMultiprocessor(&per_cu, (const void*)fwd_megakernel, 512, LDS_BYTES);
        if (per_cu < 1) { fprintf(stderr, "kernel_launch: occupancy query reports %d blocks per CU\n", per_cu); per_cu = 1; }
        if (per_cu > 1) per_cu = 1;
        grid = cus * per_cu;
        if (ws_size < WS_END) { fprintf(stderr, "kernel_launch: workspace too small (%zu < %zu)\n", ws_size, (size_t)WS_END); grid = -1; }
    }
    if (grid < 0) return;
    Params p{};
    const float** pp = (const float**)&p;
    for (int i = 0; i < 21; ++i) pp[i] = (const float*)d_in[i];
    p.out = (float*)d_out; p.ws = (unsigned char*)d_ws;
    p.never = 0;
    if (hipMemsetAsync((char*)d_ws + WS_BAR, 0, XCD_BAR_WORDS * 4, stream) != hipSuccess) { fprintf(stderr, "kernel_launch: memset of the barrier words failed\n"); return; }
    void* args[] = {&p};
    hipError_t e = hipLaunchCooperativeKernel((const void*)fwd_megakernel, dim3(grid), dim3(512), args, LDS_BYTES, stream);
    if (e != hipSuccess) fprintf(stderr, "cooperative launch failed: %s (grid %d)\n", hipGetErrorString(e), grid);
}
```

```cpp
#define PROBE_ID 0
#include <hip/hip_runtime.h>
#include <hip/hip_cooperative_groups.h>
#include <cstdio>
#include <cstdint>
namespace cg = cooperative_groups;

#define LAS __attribute__((address_space(3)))
#define DI __device__ __forceinline__
typedef unsigned short bf16_t;
typedef short bf16x8 __attribute__((ext_vector_type(8)));
typedef short s16x4 __attribute__((ext_vector_type(4)));
typedef float f32x4 __attribute__((ext_vector_type(4)));
typedef float f32x2 __attribute__((ext_vector_type(2)));
typedef float f32x16 __attribute__((ext_vector_type(16)));
typedef unsigned u32x4 __attribute__((ext_vector_type(4)));
typedef unsigned u32x2 __attribute__((ext_vector_type(2)));
typedef __bf16 bf16x2_t __attribute__((ext_vector_type(2)));
typedef short v4i16_t __attribute__((ext_vector_type(4)));

DI unsigned pk2(float lo, float hi) { f32x2 v = {lo, hi}; bf16x2_t b = __builtin_convertvector(v, bf16x2_t); return __builtin_bit_cast(unsigned, b); }
DI float bf2f(bf16_t u) { return __uint_as_float(((unsigned)u) << 16); }
DI float bflo(unsigned w) { return __uint_as_float(w << 16); }
DI float bfhi(unsigned w) { return __uint_as_float(w & 0xffff0000u); }
DI bf16_t f2bf(float f) { return (bf16_t)(pk2(f, 0.f) & 0xffffu); }
DI int get_tid() { int t = threadIdx.x; asm volatile("" : "+v"(t)); return t; }
DI int crow(int r, int hi) { return (r & 3) + 8 * (r >> 2) + 4 * hi; }
#define BAR_LDS() do { asm volatile("s_waitcnt lgkmcnt(0)" ::: "memory"); __builtin_amdgcn_s_barrier(); asm volatile("" ::: "memory"); } while (0)

constexpr int DM = 1024, NBATCH = 4, SEQ = 8192, MTOK = NBATCH * SEQ, NPROJ = 3328, FF = 4096, MEMLEN = 256;
constexpr int C_FQ = 0, C_FK = 512, C_FV = 1024, C_GQ = 1536, C_GK = 1792, C_GV = 2048, C_GR = 2560;
constexpr float EPS = 1e-6f, LOG2E = 1.4426950408889634f;
constexpr int RED_OFF = 131072;
constexpr int MISC_OFF = 131072 + 8192;
constexpr int LDS_BYTES = 131072 + 8192 + 1024;

namespace pg8 {
constexpr int BM = 256, BK = 64, HALF = 128, HTB = HALF * BK * 2, STAGE_BYTES = 8 * HTB, NXCD = 8, WGM = 4;
__host__ __device__ __forceinline__ int lds_byte(int r, int c) { const int st = (r >> 4) * 2 + (c >> 5), rr = r & 15, cc = c & 31, ob = rr * 64 + cc * 2; return st * 1024 + (ob ^ (((ob >> 9) & 1) << 5)); }
__host__ __device__ __forceinline__ void stage_rc(int b, int& R, int& C) { const int st = b / 1024, sb = b % 1024, swz = sb ^ (((sb >> 9) & 1) << 5); R = (st >> 1) * 16 + swz / 64; C = (st & 1) * 32 + (swz % 64) / 2; }
__host__ __device__ __forceinline__ int perm32(int rho) { const int n = rho >> 4, i = rho & 15; return 8 * (i >> 2) + 4 * n + (i & 3); }

struct Unit { int pm, pn; };
struct Gemm { const bf16_t* A; const bf16_t* Bt; };
template <int K_, int LDA_, int LDB_, long APN_, long BPN_, long BBATCH_, int BSHIFT_, int PNBITS_ = 30, long BPNHI_ = 0> struct Geo { static constexpr int K = K_, LDA = LDA_, LDB = LDB_, BSHIFT = BSHIFT_, PNBITS = PNBITS_; static constexpr long APN = APN_, BPN = BPN_, BBATCH = BBATCH_, BPNHI = BPNHI_; };
template <int K_> using GeoPlain = Geo<K_, K_, K_, 0, 256L * K_, 0, 0>;

struct StaticOrder {
    int nM, nN, nwg, G, c;
    __host__ __device__ void init(int M, int N, int G_, int c_) { nM = M / BM; nN = N / BM; nwg = nM * nN; G = G_; c = c_; }
    __host__ __device__ bool next(int i, Unit& u) const {
        const long L = (long)i * G + c; if (L >= nwg) return false;
        int wgid = (int)L; { const int q = nwg / NXCD, r = nwg % NXCD, xcd = wgid % NXCD, off = wgid / NXCD; wgid = (xcd < r ? xcd * (q + 1) : r * (q + 1) + (xcd - r) * q) + off; }
        const int nig = WGM * nN, gid = wgid / nig, fm = gid * WGM, gsz = (nM - fm) < WGM ? (nM - fm) : WGM;
        u.pm = fm + ((wgid % nig) % gsz); u.pn = (wgid % nig) / gsz; return true;
    }
};

typedef f32x4 Acc[2][2][4][2];

template <bool ISMAX> DI void tile_row_reduce(float (&p)[2][4], LAS float* red, int wr, int wc, int fr, int fq) {
#pragma unroll
    for (int ai = 0; ai < 2; ++ai)
#pragma unroll
        for (int m = 0; m < 4; ++m) { float v = p[ai][m]; const float a = __shfl_xor(v, 16); v = ISMAX ? fmaxf(v, a) : v + a; const float b = __shfl_xor(v, 32); v = ISMAX ? fmaxf(v, b) : v + b;
            if (fq == 0) red[(ai * 128 + wr * 64 + m * 16 + fr) * 4 + wc] = v; }
    BAR_LDS();
#pragma unroll
    for (int ai = 0; ai < 2; ++ai)
#pragma unroll
        for (int m = 0; m < 4; ++m) { const f32x4 q = *(const LAS f32x4*)(red + (ai * 128 + wr * 64 + m * 16 + fr) * 4);
            p[ai][m] = ISMAX ? fmaxf(fmaxf(q.x, q.y), fmaxf(q.z, q.w)) : (q.x + q.y) + (q.z + q.w); }
}

template <bool BASE_BF16, bool OUT_F32, bool OUT_BF16> struct EpiRes {
    static constexpr bool PERM = true;
    const void* base; float* out; bf16_t* hb; float* sumsq;
    DI void operator()(Acc& acc, const Unit& u, int wr, int wc, int fr, int fq, LAS unsigned char* lds) const {
        const int col0 = u.pn * BM + wc * 32 + 8 * fq;
        float part[2][4];
#pragma unroll
        for (int ai = 0; ai < 2; ++ai)
#pragma unroll
            for (int m = 0; m < 4; ++m) { const int row = u.pm * BM + ai * HALF + wr * 64 + m * 16 + fr; const size_t off = (size_t)row * DM + col0; float ss = 0.f;
#pragma unroll
                for (int bj = 0; bj < 2; ++bj) { const size_t o = off + bj * HALF;
                    f32x4 b0, b1;
                    if (BASE_BF16) { const u32x4 w = *(const u32x4*)((const bf16_t*)base + o); b0 = (f32x4){bflo(w.x), bfhi(w.x), bflo(w.y), bfhi(w.y)}; b1 = (f32x4){bflo(w.z), bfhi(w.z), bflo(w.w), bfhi(w.w)}; }
                    else { b0 = *(const f32x4*)((const float*)base + o); b1 = *(const f32x4*)((const float*)base + o + 4); }
                    const f32x4 v0 = b0 + acc[ai][bj][m][0], v1 = b1 + acc[ai][bj][m][1];
                    if (OUT_F32) { *(f32x4*)(out + o) = v0; *(f32x4*)(out + o + 4) = v1; }
                    if (OUT_BF16) { u32x4 w; w.x = pk2(v0.x, v0.y); w.y = pk2(v0.z, v0.w); w.z = pk2(v1.x, v1.y); w.w = pk2(v1.z, v1.w); *(u32x4*)(hb + o) = w;
                        ss += ((v0.x * v0.x + v0.y * v0.y) + (v0.z * v0.z + v0.w * v0.w)) + ((v1.x * v1.x + v1.y * v1.y) + (v1.z * v1.z + v1.w * v1.w)); } }
                part[ai][m] = ss; }
        if (OUT_BF16) {
            tile_row_reduce<false>(part, (LAS float*)(lds + RED_OFF), wr, wc, fr, fq);
            if (wc == 0 && fq == 0) {
#pragma unroll
                for (int ai = 0; ai < 2; ++ai)
#pragma unroll
                    for (int m = 0; m < 4; ++m) sumsq[(size_t)(u.pm * BM + ai * HALF + wr * 64 + m * 16 + fr) * 4 + u.pn] = part[ai][m]; }
        }
    }
};
template <int ldc, int act, bool HAS_RS, int aux_pn> struct EpiBf {
    static constexpr bool PERM = true;
    bf16_t* O; const float* sumsq; float* aux;
    DI void operator()(Acc& acc, const Unit& u, int wr, int wc, int fr, int fq, LAS unsigned char*) const {
        if (aux_pn >= 0 && u.pn == aux_pn) {
            if (wc == 0) {
#pragma unroll
                for (int ai = 0; ai < 2; ++ai)
#pragma unroll
                    for (int m = 0; m < 4; ++m) { const int row = u.pm * BM + ai * HALF + wr * 64 + m * 16 + fr;
#pragma unroll
                        for (int n = 0; n < 2; ++n) *(f32x4*)(aux + (size_t)row * 32 + 8 * fq + 4 * n) = acc[ai][0][m][n]; } }
            return; }
        const int col0 = u.pn * BM + wc * 32 + 8 * fq;
#pragma unroll
        for (int ai = 0; ai < 2; ++ai)
#pragma unroll
            for (int m = 0; m < 4; ++m) { const int row = u.pm * BM + ai * HALF + wr * 64 + m * 16 + fr; bf16_t* rowp = O + (size_t)row * ldc + col0;
                float rs = 1.0f; if (HAS_RS) { const f32x4 q4 = *(const f32x4*)(sumsq + (size_t)row * 4); rs = rsqrtf(((q4.x + q4.y) + (q4.z + q4.w)) * (1.0f / DM) + EPS); }
#pragma unroll
                for (int bj = 0; bj < 2; ++bj) { f32x4 v0 = acc[ai][bj][m][0] * rs, v1 = acc[ai][bj][m][1] * rs;
                    if (act) { v0 = __builtin_elementwise_max(v0, (f32x4){0.f, 0.f, 0.f, 0.f}); v1 = __builtin_elementwise_max(v1, (f32x4){0.f, 0.f, 0.f, 0.f}); v0 = v0 * v0; v1 = v1 * v1; }
                    u32x4 w; w.x = pk2(v0.x, v0.y); w.y = pk2(v0.z, v0.w); w.z = pk2(v1.x, v1.y); w.w = pk2(v1.z, v1.w);
                    if (act) __builtin_nontemporal_store(w, (u32x4*)(rowp + bj * HALF)); else *(u32x4*)(rowp + bj * HALF) = w; } }
    }
};
struct EpiProj {
    static constexpr bool PERM = true;
    bf16_t* O; float* aux; const float* gq; const float* gk;
    DI void operator()(Acc& acc, const Unit& u, int wr, int wc, int fr, int fq, LAS unsigned char* lds) const {
        if (u.pn == 12) {
            if (wc == 0) {
#pragma unroll
                for (int ai = 0; ai < 2; ++ai)
#pragma unroll
                    for (int m = 0; m < 4; ++m) { const int row = u.pm * BM + ai * HALF + wr * 64 + m * 16 + fr;
#pragma unroll
                        for (int n = 0; n < 2; ++n) *(f32x4*)(aux + (size_t)row * 32 + 8 * fq + 4 * n) = acc[ai][0][m][n]; } }
            return; }
        const int col0 = u.pn * BM + wc * 32 + 8 * fq;
        if (u.pn < 4) {
            LAS float* red = (LAS float*)(lds + RED_OFF);
#pragma unroll
            for (int ai = 0; ai < 2; ++ai)
#pragma unroll
                for (int m = 0; m < 4; ++m)
#pragma unroll
                    for (int bj = 0; bj < 2; ++bj) { const f32x4 v0 = acc[ai][bj][m][0], v1 = acc[ai][bj][m][1];
                        float ss = ((v0.x * v0.x + v0.y * v0.y) + (v0.z * v0.z + v0.w * v0.w)) + ((v1.x * v1.x + v1.y * v1.y) + (v1.z * v1.z + v1.w * v1.w));
                        ss += __shfl_xor(ss, 16); ss += __shfl_xor(ss, 32);
                        if (fq == 0) red[(ai * 128 + wr * 64 + m * 16 + fr) * 8 + bj * 4 + wc] = ss; }
            BAR_LDS();
            const bool isk = u.pn >= 2; const float* g = (isk ? gk : gq) + 32 * (wc & 1) + 8 * fq; const float sc = isk ? 1.0f : 0.125f * LOG2E;
            const f32x4 g0 = *(const f32x4*)g, g1 = *(const f32x4*)(g + 4);
#pragma unroll
            for (int ai = 0; ai < 2; ++ai)
#pragma unroll
                for (int m = 0; m < 4; ++m) { const int rl = ai * HALF + wr * 64 + m * 16 + fr; bf16_t* rowp = O + (size_t)(u.pm * BM + rl) * NPROJ + col0;
#pragma unroll
                    for (int bj = 0; bj < 2; ++bj) { const f32x2 pr = *(const LAS f32x2*)(red + rl * 8 + bj * 4 + (wc & 2)); const float tot = pr.x + pr.y; const float rs = rsqrtf(tot * (1.0f / 64.0f) + EPS) * sc;
                        const f32x4 v0 = acc[ai][bj][m][0] * rs * g0, v1 = acc[ai][bj][m][1] * rs * g1;
                        u32x4 w; w.x = pk2(v0.x, v0.y); w.y = pk2(v0.z, v0.w); w.z = pk2(v1.x, v1.y); w.w = pk2(v1.z, v1.w); *(u32x4*)(rowp + bj * HALF) = w; } }
            return; }
#pragma unroll
        for (int ai = 0; ai < 2; ++ai)
#pragma unroll
            for (int m = 0; m < 4; ++m) { const int row = u.pm * BM + ai * HALF + wr * 64 + m * 16 + fr; bf16_t* rowp = O + (size_t)row * NPROJ + col0;
#pragma unroll
                for (int bj = 0; bj < 2; ++bj) { const f32x4 v0 = acc[ai][bj][m][0], v1 = acc[ai][bj][m][1];
                    u32x4 w; w.x = pk2(v0.x, v0.y); w.y = pk2(v0.z, v0.w); w.z = pk2(v1.x, v1.y); w.w = pk2(v1.z, v1.w); *(u32x4*)(rowp + bj * HALF) = w; } }
    }
};
struct EpiNorm {
    static constexpr bool PERM = true;
    bf16_t* O; const float* sumsq; const float* gain; float scale; bf16_t* vt;
    DI void operator()(Acc& acc, const Unit& u, int wr, int wc, int fr, int fq, LAS unsigned char* lds) const {
        if (vt && u.pn >= 4) {
#pragma unroll
            for (int ai = 0; ai < 2; ++ai)
#pragma unroll
                for (int m = 0; m < 4; ++m) { const int row = u.pm * BM + ai * HALF + wr * 64 + m * 16 + fr; bf16_t* rowp = vt + (size_t)row * DM + (u.pn - 4) * BM + wc * 32 + 8 * fq;
#pragma unroll
                    for (int bj = 0; bj < 2; ++bj) { const f32x4 v0 = acc[ai][bj][m][0], v1 = acc[ai][bj][m][1];
                        u32x4 w; w.x = pk2(v0.x, v0.y); w.y = pk2(v0.z, v0.w); w.z = pk2(v1.x, v1.y); w.w = pk2(v1.z, v1.w); *(u32x4*)(rowp + bj * HALF) = w; } }
            return; }
        LAS float* red = (LAS float*)(lds + RED_OFF);
        float part[2][4];
#pragma unroll
        for (int ai = 0; ai < 2; ++ai)
#pragma unroll
            for (int m = 0; m < 4; ++m) { const int row = u.pm * BM + ai * HALF + wr * 64 + m * 16 + fr;
                float rs = 1.0f; if (sumsq) { const f32x4 q4 = *(const f32x4*)(sumsq + (size_t)row * 4); rs = rsqrtf(((q4.x + q4.y) + (q4.z + q4.w)) * (1.0f / DM) + EPS); } float ss = 0.f;
#pragma unroll
                for (int bj = 0; bj < 2; ++bj)
#pragma unroll
                    for (int n = 0; n < 2; ++n) { const f32x4 v = acc[ai][bj][m][n] * rs; acc[ai][bj][m][n] = v; ss += (v.x * v.x + v.y * v.y) + (v.z * v.z + v.w * v.w); }
                part[ai][m] = ss; }
        tile_row_reduce<false>(part, red, wr, wc, fr, fq);
        const int cin = wc * 32 + 8 * fq;
#pragma unroll
        for (int ai = 0; ai < 2; ++ai)
#pragma unroll
            for (int m = 0; m < 4; ++m) { const int row = u.pm * BM + ai * HALF + wr * 64 + m * 16 + fr; const float rn = rsqrtf(part[ai][m] * (1.0f / 256.0f) + EPS) * scale;
                bf16_t* rowp = O + (size_t)row * DM + u.pn * BM + cin;
#pragma unroll
                for (int bj = 0; bj < 2; ++bj) { const f32x4 g0 = *(const f32x4*)(gain + bj * HALF + cin), g1 = *(const f32x4*)(gain + bj * HALF + cin + 4);
                    const f32x4 v0 = acc[ai][bj][m][0] * rn * g0, v1 = acc[ai][bj][m][1] * rn * g1;
                    u32x4 w; w.x = pk2(v0.x, v0.y); w.y = pk2(v0.z, v0.w); w.z = pk2(v1.x, v1.y); w.w = pk2(v1.z, v1.w); __builtin_nontemporal_store(w, (u32x4*)(rowp + bj * HALF)); } }
    }
};
struct EpiSoftmax {
    static constexpr bool PERM = true;
    bf16_t* O;
    DI void operator()(Acc& acc, const Unit& u, int wr, int wc, int fr, int fq, LAS unsigned char* lds) const {
        LAS float* red = (LAS float*)(lds + RED_OFF);
        float part[2][4];
#pragma unroll
        for (int ai = 0; ai < 2; ++ai)
#pragma unroll
            for (int m = 0; m < 4; ++m) { float mx = -3.0e38f;
#pragma unroll
                for (int bj = 0; bj < 2; ++bj)
#pragma unroll
                    for (int n = 0; n < 2; ++n) { const f32x4 v = acc[ai][bj][m][n]; mx = fmaxf(mx, fmaxf(fmaxf(v.x, v.y), fmaxf(v.z, v.w))); }
                part[ai][m] = mx; }
        tile_row_reduce<true>(part, red, wr, wc, fr, fq);
        float part2[2][4];
#pragma unroll
        for (int ai = 0; ai < 2; ++ai)
#pragma unroll
            for (int m = 0; m < 4; ++m) { const float mx = part[ai][m] * LOG2E; float s = 0.f;
#pragma unroll
                for (int bj = 0; bj < 2; ++bj)
#pragma unroll
                    for (int n = 0; n < 2; ++n) { f32x4 v = acc[ai][bj][m][n];
#pragma unroll
                        for (int e = 0; e < 4; ++e) { v[e] = __builtin_amdgcn_exp2f(v[e] * LOG2E - mx); s += v[e]; }
                        acc[ai][bj][m][n] = v; }
                part2[ai][m] = s; }
        tile_row_reduce<false>(part2, red + 1024, wr, wc, fr, fq);
        const int cin = wc * 32 + 8 * fq;
#pragma unroll
        for (int ai = 0; ai < 2; ++ai)
#pragma unroll
            for (int m = 0; m < 4; ++m) { const int row = u.pm * BM + ai * HALF + wr * 64 + m * 16 + fr; const float inv = 1.0f / part2[ai][m];
                bf16_t* rowp = O + (size_t)row * DM + u.pn * BM + cin;
#pragma unroll
                for (int bj = 0; bj < 2; ++bj) { const f32x4 v0 = acc[ai][bj][m][0] * inv, v1 = acc[ai][bj][m][1] * inv;
                    u32x4 w; w.x = pk2(v0.x, v0.y); w.y = pk2(v0.z, v0.w); w.z = pk2(v1.x, v1.y); w.w = pk2(v1.z, v1.w); *(u32x4*)(rowp + bj * HALF) = w; } }
    }
};

template <class GEO, class Epi>
__device__ __forceinline__ void gemm_phase(LAS unsigned char* lds, const Gemm g, const StaticOrder& S, const Epi& E) {
    const int tid = get_tid(), wid = __builtin_amdgcn_readfirstlane(tid >> 6), lane = tid & 63, wr = wid >> 2, wc = wid & 3, fr = lane & 15, fq = lane >> 4;
    constexpr int K = GEO::K, nt = K / BK;
    unsigned voffA[2], voffB[2];
#pragma unroll
    for (int i = 0; i < 2; ++i) { int R, C; stage_rc(tid * 16 + i * 8192, R, C); const int Rb = Epi::PERM ? ((R & ~31) + perm32(R & 31)) : R;
        voffA[i] = (unsigned)(R * GEO::LDA + C) * 2u; voffB[i] = (unsigned)(Rb * GEO::LDB + C) * 2u; }
    const size_t kstep = (size_t)(BK * 2);
    constexpr size_t hstepA = (size_t)HALF * GEO::LDA * 2, hstepB = (size_t)HALF * GEO::LDB * 2;
    const unsigned ldsw = (unsigned)wid * 1024u;
    const int aoff = lds_byte(wr * 64 + fr, fq * 8), boff = lds_byte(wc * 32 + fr, fq * 8);
#define PG8_SA(b, h) (((b) * 2 + (h)) * HTB)
#define PG8_SB(b, h) ((4 + (b) * 2 + (h)) * HTB)
#define PG8_STAGE(bufoff, gbase, voff) do { _Pragma("unroll") for (int _i = 0; _i < 2; ++_i) \
        __builtin_amdgcn_global_load_lds((const unsigned*)((const char*)(gbase) + (voff)[_i]), (LAS unsigned*)(lds + (bufoff) + ldsw + _i * 8192), 16, 0, 0); } while (0)
#define PG8_LDA(dst, b, h) do { _Pragma("unroll") for (int m = 0; m < 4; ++m) _Pragma("unroll") for (int k = 0; k < 2; ++k) dst[m][k] = *(const LAS bf16x8*)(lds + PG8_SA(b, h) + aoff + m * 2048 + k * 1024); } while (0)
#define PG8_LDB(dst, b, h) do { _Pragma("unroll") for (int n = 0; n < 2; ++n) _Pragma("unroll") for (int k = 0; k < 2; ++k) dst[n][k] = *(const LAS bf16x8*)(lds + PG8_SB(b, h) + boff + n * 2048 + k * 1024); } while (0)
#define PG8_MMA(ai, bj, At, Bt) do { __builtin_amdgcn_s_setprio(1); _Pragma("unroll") for (int m = 0; m < 4; ++m) _Pragma("unroll") for (int n = 0; n < 2; ++n) _Pragma("unroll") for (int k = 0; k < 2; ++k) \
        acc[ai][bj][m][n] = __builtin_amdgcn_mfma_f32_16x16x32_bf16(Bt[n][k], At[m][k], acc[ai][bj][m][n], 0, 0, 0); __builtin_amdgcn_s_setprio(0); } while (0)
#define PG8_WAIT_V(n) asm volatile("s_waitcnt vmcnt(" #n ")" ::: "memory")
#define PG8_WAIT_L(n) asm volatile("s_waitcnt lgkmcnt(" #n ")" ::: "memory")
#define PG8_BAR __builtin_amdgcn_s_barrier()
#define PG8_SCHED __builtin_amdgcn_sched_barrier(0)
#define PG8_APTR(u) ((const char*)g.A + ((size_t)(u).pm * BM * GEO::LDA + (size_t)((u).pn & ((1 << GEO::PNBITS) - 1)) * GEO::APN) * 2)
#define PG8_BPTR(u) ((const char*)g.Bt + ((size_t)((u).pn & ((1 << GEO::PNBITS) - 1)) * GEO::BPN + (size_t)((u).pn >> GEO::PNBITS) * GEO::BPNHI + (size_t)((u).pm >> GEO::BSHIFT) * GEO::BBATCH) * 2)
    Unit cur, nxt; int ui = 0;
    if (!S.next(0, cur)) return;
    Acc acc;
#pragma unroll
    for (int a = 0; a < 2; ++a)
#pragma unroll
        for (int b = 0; b < 2; ++b)
#pragma unroll
            for (int m = 0; m < 4; ++m)
#pragma unroll
                for (int n = 0; n < 2; ++n) acc[a][b][m][n] = (f32x4){0.f, 0.f, 0.f, 0.f};
    bf16x8 At[4][2], B0[2][2], B1[2][2];
    const char* cA = PG8_APTR(cur); const char* cB = PG8_BPTR(cur);
    PG8_STAGE(PG8_SB(0, 0), cB, voffB); PG8_STAGE(PG8_SB(0, 1), cB + hstepB, voffB); PG8_STAGE(PG8_SA(0, 0), cA, voffA); PG8_STAGE(PG8_SA(0, 1), cA + hstepA, voffA);
    if (wr == 1) PG8_BAR;
    PG8_WAIT_V(2); PG8_BAR;
    PG8_STAGE(PG8_SB(1, 0), cB + kstep, voffB); PG8_STAGE(PG8_SA(1, 0), cA + kstep, voffA); PG8_STAGE(PG8_SB(1, 1), cB + hstepB + kstep, voffB);
    PG8_WAIT_V(6); PG8_BAR;
    for (;;) {
        const bool has_next = S.next(ui + 1, nxt);
        const char* nA = has_next ? PG8_APTR(nxt) : cA; const char* nB = has_next ? PG8_BPTR(nxt) : cB;
#pragma nounroll
        for (int t = 0; t < nt; t += 2) {
            const bool last = (t == nt - 2);
            const char* a1 = cA + (size_t)(t + 1) * kstep;
            const char* a2 = last ? nA : cA + (size_t)(t + 2) * kstep; const char* b2 = last ? nB : cB + (size_t)(t + 2) * kstep;
            const char* a3 = a2 + kstep; const char* b3 = b2 + kstep;
            PG8_LDB(B0, 0, 0); PG8_LDB(B1, 0, 1); PG8_SCHED; PG8_LDA(At, 0, 0); PG8_STAGE(PG8_SA(1, 1), a1 + hstepA, voffA);
            PG8_WAIT_V(8); PG8_WAIT_L(0); PG8_BAR; PG8_MMA(0, 0, At, B0); PG8_MMA(0, 1, At, B1); PG8_BAR; PG8_SCHED;
            PG8_LDA(At, 0, 1); PG8_STAGE(PG8_SB(0, 0), b2, voffB); PG8_STAGE(PG8_SB(0, 1), b2 + hstepB, voffB); PG8_STAGE(PG8_SA(0, 0), a2, voffA);
            PG8_WAIT_V(8); PG8_WAIT_L(0); PG8_BAR; PG8_MMA(1, 0, At, B0); PG8_MMA(1, 1, At, B1); PG8_BAR; PG8_SCHED;
            PG8_LDB(B0, 1, 0); PG8_LDB(B1, 1, 1); PG8_SCHED; PG8_LDA(At, 1, 0); PG8_STAGE(PG8_SA(0, 1), a2 + hstepA, voffA);
            PG8_WAIT_V(8); PG8_WAIT_L(0); PG8_BAR; PG8_MMA(0, 0, At, B0); PG8_MMA(0, 1, At, B1); PG8_BAR; PG8_SCHED;
            PG8_LDA(At, 1, 1); PG8_STAGE(PG8_SB(1, 0), b3, voffB); PG8_STAGE(PG8_SB(1, 1), b3 + hstepB, voffB); PG8_STAGE(PG8_SA(1, 0), a3, voffA);
            PG8_WAIT_V(8); PG8_WAIT_L(0); PG8_BAR; PG8_MMA(1, 0, At, B0); PG8_MMA(1, 1, At, B1); PG8_BAR; PG8_SCHED;
        }
        if (wr == 0) PG8_BAR;
        E(acc, cur, wr, wc, fr, fq, lds);
        if (!has_next) break;
#pragma unroll
        for (int a = 0; a < 2; ++a)
#pragma unroll
            for (int b = 0; b < 2; ++b)
#pragma unroll
                for (int m = 0; m < 4; ++m)
#pragma unroll
                    for (int n = 0; n < 2; ++n) acc[a][b][m][n] = (f32x4){0.f, 0.f, 0.f, 0.f};
        cur = nxt; cA = nA; cB = nB; ++ui;
        if (wr == 1) PG8_BAR;
    }
    PG8_WAIT_V(0);
    PG8_BAR;
#undef PG8_SA
#undef PG8_SB
#undef PG8_STAGE
#undef PG8_LDA
#undef PG8_LDB
#undef PG8_MMA
#undef PG8_WAIT_V
#undef PG8_WAIT_L
#undef PG8_BAR
#undef PG8_SCHED
#undef PG8_APTR
#undef PG8_BPTR
}
}

constexpr size_t MiB = 1u << 20;
constexpr size_t WS_SUMSQ1 = 0, WS_SUMSQ2 = 1024 * 1024, WS_BAR = 512 * 1024;
constexpr size_t WS_WIN = 2 * MiB, WS_WOUT = 9 * MiB, WS_WQ = 11 * MiB, WS_WKV = 13 * MiB, WS_WO = 17 * MiB, WS_W1 = 19 * MiB, WS_W2 = 27 * MiB;
constexpr size_t WS_MEMN = 36 * MiB, WS_KN = 38 * MiB, WS_VT = 40 * MiB, WS_AUX = 42 * MiB;
constexpr size_t WS_CLOC = 46 * MiB, WS_CTOT = 47 * MiB, WS_DECAY = 47 * MiB + 65536;
constexpr size_t WS_XN = 48 * MiB, WS_DST = 48 * MiB, WS_U = 48 * MiB;
constexpr size_t WS_PROJ = 112 * MiB, WS_QN = 112 * MiB, WS_P = 176 * MiB;
constexpr size_t WS_VWT = 480 * MiB;
constexpr size_t WS_SPT = 320 * MiB, WS_MIX = 352 * MiB, WS_HB = 416 * MiB, WS_END = 488 * MiB;

struct Params {
    const float *x, *mem, *norm_mix_g, *w_in, *fox_b_f, *fox_q_g, *fox_k_g, *gla_w2, *gla_bg, *gla_og, *w_out, *norm_x_g, *norm_mem_g, *wq, *wkv, *xq_g, *xk_g, *wo, *norm_mlp_g, *w1, *w2;
    float* out; unsigned char* ws;
    long never;
};

DI float wave_sum(float v) {
#pragma unroll
    for (int o = 1; o < 64; o <<= 1) v += __shfl_xor(v, o);
    return v;
}
DI float logsig(float z) { return fminf(z, 0.f) - log1pf(expf(-fabsf(z))); }
DI float logsig_fast(float z) { return fminf(z, 0.f) - __logf(1.0f + __expf(-fabsf(z))); }

DI void p0_transpose_item(const float* W, int ldw, int src0, int K, bf16_t* WT, int dst0, const float* gain, LAS float* scr, int kb, int nb, int lane) {
    const int k0 = 64 * kb, n0 = 32 * nb, kr = lane >> 3, c4 = lane & 7;
    f32x4 v[8];
#pragma unroll
    for (int i = 0; i < 8; ++i) v[i] = __builtin_nontemporal_load((const f32x4*)(W + (size_t)(k0 + kr + 8 * i) * ldw + src0 + n0 + 4 * c4));
#pragma unroll
    for (int i = 0; i < 8; ++i) { const float g = gain ? gain[k0 + kr + 8 * i] : 1.0f; LAS float* d = scr + (kr + 8 * i) * 33 + 4 * c4; d[0] = v[i].x * g; d[1] = v[i].y * g; d[2] = v[i].z * g; d[3] = v[i].w * g; }
    asm volatile("s_waitcnt lgkmcnt(0)" ::: "memory");
    const int c = lane & 7;
#pragma unroll
    for (int j = 0; j < 4; ++j) { const int n = (lane >> 3) + 8 * j; const LAS float* s = scr + (8 * c) * 33 + n;
        u32x4 o; o.x = pk2(s[0 * 33], s[1 * 33]); o.y = pk2(s[2 * 33], s[3 * 33]); o.z = pk2(s[4 * 33], s[5 * 33]); o.w = pk2(s[6 * 33], s[7 * 33]);
        *(u32x4*)(WT + (size_t)(dst0 + n0 + n) * K + k0 + 8 * c) = o; }
    asm volatile("s_waitcnt lgkmcnt(0)" ::: "memory");
}
template <int NR> DI void rms_rows_load(f32x4 (&v)[NR][4], const float* xrow, int lane) {
#pragma unroll
    for (int r = 0; r < NR; ++r) { const f32x4* xr = (const f32x4*)(xrow + (size_t)r * DM) + lane;
#pragma unroll
        for (int j = 0; j < 4; ++j) v[r][j] = __builtin_nontemporal_load(xr + 64 * j); }
}
template <int NR> DI void rms_rows_store(const f32x4 (&v)[NR][4], const float* g, bf16_t* orow, int lane) {
    float s[NR];
#pragma unroll
    for (int r = 0; r < NR; ++r) { float a = 0.f;
#pragma unroll
        for (int j = 0; j < 4; ++j) a += (v[r][j].x * v[r][j].x + v[r][j].y * v[r][j].y) + (v[r][j].z * v[r][j].z + v[r][j].w * v[r][j].w);
        s[r] = a; }
#pragma unroll
    for (int o = 1; o < 64; o <<= 1)
#pragma unroll
        for (int r = 0; r < NR; ++r) s[r] += __shfl_xor(s[r], o);
    const f32x4* gr = (const f32x4*)g + lane;
#pragma unroll
    for (int j = 0; j < 4; ++j) { const f32x4 gg = gr[64 * j];
#pragma unroll
        for (int r = 0; r < NR; ++r) { const float rstd = rsqrtf(s[r] * (1.f / DM) + EPS); u32x2 w; w.x = pk2(v[r][j].x * rstd * gg.x, v[r][j].y * rstd * gg.y); w.y = pk2(v[r][j].z * rstd * gg.z, v[r][j].w * rstd * gg.w);
            ((u32x2*)(orow + (size_t)r * DM) + lane)[64 * j] = w; } }
}
DI void late_transposes(const Params& p, LAS unsigned char* lds, int gwv, int ngw) {
    const int tid = get_tid(), lane = tid & 63, wave = tid >> 6;
    unsigned char* ws = p.ws;
    LAS float* scr = (LAS float*)(lds + wave * 16384);
    constexpr int J3 = 16 * 32, J4 = 16 * 32, J6 = 16 * 32, J7 = 16 * 128, J8 = 64 * 32;
    for (int it = gwv; it < J3 + J4 + J6 + J7 + J8; it += ngw) {
        int r = it;
        if (r < J3) { p0_transpose_item(p.w_out, DM, 0, DM, (bf16_t*)(ws + WS_WOUT), 0, nullptr, scr, r / 32, r % 32, lane); continue; } r -= J3;
        if (r < J4) { p0_transpose_item(p.wq, DM, 0, DM, (bf16_t*)(ws + WS_WQ), 0, p.norm_x_g, scr, r / 32, r % 32, lane); continue; } r -= J4;
        if (r < J6) { p0_transpose_item(p.wo, DM, 0, DM, (bf16_t*)(ws + WS_WO), 0, nullptr, scr, r / 32, r % 32, lane); continue; } r -= J6;
        if (r < J7) { p0_transpose_item(p.w1, FF, 0, DM, (bf16_t*)(ws + WS_W1), 0, p.norm_mlp_g, scr, r / 128, r % 128, lane); continue; } r -= J7;
        p0_transpose_item(p.w2, DM, 0, FF, (bf16_t*)(ws + WS_W2), 0, nullptr, scr, r / 32, r % 32, lane);
    }
}
DI void p0_prologue(const Params& p, LAS unsigned char* lds, int G) {
    const int tid = get_tid(), lane = tid & 63, wave = tid >> 6;
    unsigned char* ws = p.ws;
    LAS float* scr = (LAS float*)(lds + wave * 16384);
    const int gw = blockIdx.x * 8 + wave, NGW = G * 8;
    constexpr int I0 = 16 * 48, I1 = 16 * 32, I2 = 16 * 16, I3 = 16 * 32, I4 = 16 * 32, I5 = 16 * 64, I6 = 16 * 32, I7 = 16 * 128, I8 = 64 * 32;
    constexpr int NITEMS = I0 + I1 + I2 + I3 + I4 + I5 + I6 + I7 + I8;
    const int wu = __builtin_amdgcn_readfirstlane(wave);
    for (int ph = 0; ph < 2; ++ph) {
    if (((ph ^ wu) & 1) == 1) {
    for (int r16 = 0; r16 < (PROBE_ID == 16 ? 2 : 1); ++r16) {
    for (int it = gw; it < I0 + I1 + I2 + I5; it += NGW) {
        int r = it;
        if (r < I0) { p0_transpose_item(p.w_in, 3096, 0, DM, (bf16_t*)(ws + WS_WIN), 0, nullptr, scr, r / 48, r % 48, lane); continue; } r -= I0;
        if (r < I1) { p0_transpose_item(p.w_in, 3096, 1544, DM, (bf16_t*)(ws + WS_WIN), 1536, nullptr, scr, r / 32, r % 32, lane); continue; } r -= I1;
        if (r < I2) { p0_transpose_item(p.w_in, 3096, 2584, DM, (bf16_t*)(ws + WS_WIN), 2560, nullptr, scr, r / 16, r % 16, lane); continue; } r -= I2;
        p0_transpose_item(p.wkv, 2 * DM, 0, DM, (bf16_t*)(ws + WS_WKV), 0, nullptr, scr, r / 64, r % 64, lane);
    }
    }
    } else {
    for (int r15 = 0; r15 < (PROBE_ID == 15 ? 2 : 1); ++r15)
    { f32x4 va[4][4], vb[4][4];
      int m = gw * 4;
      if (m < MTOK) rms_rows_load<4>(va, p.x + (size_t)m * DM, lane);
      for (; m < MTOK; m += NGW * 8) {
          const int m1 = m + NGW * 4, m2 = m + NGW * 8;
          if (m1 < MTOK) rms_rows_load<4>(vb, p.x + (size_t)m1 * DM, lane);
          rms_rows_store<4>(va, p.norm_mix_g, (bf16_t*)(ws + WS_XN) + (size_t)m * DM, lane);
          if (m2 < MTOK) rms_rows_load<4>(va, p.x + (size_t)m2 * DM, lane);
          if (m1 < MTOK) rms_rows_store<4>(vb, p.norm_mix_g, (bf16_t*)(ws + WS_XN) + (size_t)m1 * DM, lane);
      } }
    }
    }
    if (G != 256) late_transposes(p, lds, gw, NGW);
    { bf16_t* wt = (bf16_t*)(ws + WS_WIN) + (size_t)3072 * DM;
      for (int idx = blockIdx.x * 512 + tid; idx < 256 * DM; idx += G * 512) { const int r = idx >> 10, k = idx & 1023; float w = 0.f;
          if (r < 8) w = p.w_in[(size_t)k * 3096 + 1536 + r]; else if (r < 24) w = p.w_in[(size_t)k * 3096 + 2568 + (r - 8)];
          wt[idx] = f2bf(w); } }
    for (int m = gw; m < NBATCH * MEMLEN; m += NGW) { f32x4 v1[1][4]; rms_rows_load<1>(v1, p.mem + (size_t)m * DM, lane); rms_rows_store<1>(v1, p.norm_mem_g, (bf16_t*)(ws + WS_MEMN) + (size_t)m * DM, lane); }
}

constexpr int VT_PITCH = 72;
constexpr int L2_VT = 0, L2_KDT = 73728, L2_AUX = 110592, L2_DEC = 118784;
constexpr int VS_PITCH = 544;
DI void stage_vT(const bf16_t* proj, int tok0, LAS unsigned char* lds, int tid) {
    LAS bf16_t* vS = (LAS bf16_t*)(lds + L2_VT);
    u32x4 w[8];
#pragma unroll
    for (int i8 = 0; i8 < 8; ++i8) { const int piece = tid + 512 * i8, row = piece >> 6, cp = piece & 63; w[i8] = *(const u32x4*)(proj + (size_t)(tok0 + row) * NPROJ + C_GV + cp * 8); }
#pragma unroll
    for (int i8 = 0; i8 < 8; ++i8) { const int piece = tid + 512 * i8, row = piece >> 6, cp = piece & 63; *(LAS u32x4*)(vS + row * VS_PITCH + cp * 8) = w[i8]; }
}
template <int PITCH = VS_PITCH> DI bf16x8 vs_frag(const LAS bf16_t* vS, int row0, int rstep, int col0, int lane) {
    const LAS bf16_t* vp = vS + (row0 + ((lane & 15) >> 2)) * PITCH + col0 + 16 * ((lane >> 4) & 1) + 4 * (lane & 3);
    const s16x4 lo = __builtin_bit_cast(s16x4, __builtin_amdgcn_ds_read_tr16_b64_v4i16((LAS v4i16_t*)vp));
    const s16x4 hh = __builtin_bit_cast(s16x4, __builtin_amdgcn_ds_read_tr16_b64_v4i16((LAS v4i16_t*)(vp + rstep * PITCH)));
    return __builtin_shufflevector(lo, hh, 0, 1, 2, 3, 4, 5, 6, 7);
}
constexpr int KD_PITCH = 288;
DI void p2_unit(int chunk, const Params& p, LAS unsigned char* lds) {
    const int tid = get_tid(), lane = tid & 63, wid = __builtin_amdgcn_readfirstlane(tid >> 6), r32 = lane & 31, hi = lane >> 5;
    unsigned char* ws = p.ws;
    bf16_t* proj = (bf16_t*)(ws + WS_PROJ); const float* aux = (const float*)(ws + WS_AUX);
    const int b = chunk >> 7, n = chunk & 127, tok0 = chunk * 64;
    LAS bf16_t* vT = (LAS bf16_t*)(lds + L2_VT); LAS bf16_t* kdT = (LAS bf16_t*)(lds + L2_KDT); LAS float* auxs = (LAS float*)(lds + L2_AUX); LAS float* decs = (LAS float*)(lds + L2_DEC);
    stage_vT(proj, tok0, lds, tid);
    if (wid >= 4) { const int wj = wid - 4;
#pragma unroll
        for (int hh = 0; hh < 2; ++hh) { const int h = 2 * wj + hh;
            float v = logsig(aux[(size_t)(tok0 + lane) * 32 + h] + p.fox_b_f[h]) * LOG2E;
#pragma unroll
            for (int o = 1; o < 64; o <<= 1) { const float t = __shfl_up(v, o); if (lane >= o) v += t; }
            ((float*)(ws + WS_CLOC))[(size_t)(b * 8 + h) * SEQ + n * 64 + lane] = v;
            if (lane == 63) ((float*)(ws + WS_CTOT))[(b * 8 + h) * 128 + n] = v; } }
    { const int col = tid & 255, half = tid >> 8, t0 = 32 * half, t0u = __builtin_amdgcn_readfirstlane(t0);
      LAS float* tots = (LAS float*)(lds + L2_DEC) + 256;
      float w2c[16];
#pragma unroll
      for (int r = 0; r < 16; ++r) w2c[r] = p.gla_w2[r * 256 + col];
      const float bgc = p.gla_bg[col];
      bf16_t* pq = proj + (size_t)(tok0 + t0) * NPROJ + C_GQ + col; bf16_t* pk = proj + (size_t)(tok0 + t0) * NPROJ + C_GK + col;
      bf16_t qv32[32], kv32[32];
#pragma unroll
      for (int j2 = 0; j2 < 32; ++j2) { qv32[j2] = pq[(size_t)j2 * NPROJ]; kv32[j2] = pk[(size_t)j2 * NPROJ]; }
      float lc[32]; float bc = 0.f;
#pragma unroll
      for (int j2 = 0; j2 < 32; ++j2) { const f32x4* ar = (const f32x4*)(aux + (size_t)(tok0 + t0u + j2) * 32 + 8);
          float z = bgc;
#pragma unroll
          for (int r4 = 0; r4 < 4; ++r4) { const f32x4 a = ar[r4]; z += a.x * w2c[4 * r4] + a.y * w2c[4 * r4 + 1] + a.z * w2c[4 * r4 + 2] + a.w * w2c[4 * r4 + 3]; }
          bc += logsig_fast(z) * (1.0f / 16.0f); lc[j2] = bc; }
      if (half == 0) tots[col] = bc;
      __syncthreads();
      const float offs = half ? tots[col] : 0.f;
#pragma unroll
      for (int j2 = 0; j2 < 32; ++j2) { const float bcl = (offs + lc[j2]) * LOG2E;
          const float qd = bf2f(qv32[j2]) * 0.125f * __builtin_amdgcn_exp2f(bcl), kd = bf2f(kv32[j2]) * __builtin_amdgcn_exp2f(-bcl);
          const bf16_t kdb = f2bf(kd);
          pq[(size_t)j2 * NPROJ] = f2bf(qd); pk[(size_t)j2 * NPROJ] = kdb; kdT[(t0 + j2) * KD_PITCH + col] = kdb; }
      if (half) { const float dec = __builtin_amdgcn_exp2f((offs + bc) * LOG2E); decs[col] = dec; ((float*)(ws + WS_DECAY))[(size_t)(b * 128 + n) * 256 + col] = dec; }
    }
    __syncthreads();
    { const int h = wid >> 1, vb0 = (wid & 1) * 2, bh = b * 4 + h;
      f32x16 d[2][2];
#pragma unroll
      for (int i = 0; i < 2; ++i)
#pragma unroll
          for (int j = 0; j < 2; ++j)
#pragma unroll
              for (int e = 0; e < 16; ++e) d[i][j][e] = 0.f;
#pragma unroll
      for (int s = 0; s < 4; ++s) { bf16x8 a[2], bb[2];
#pragma unroll
          for (int i = 0; i < 2; ++i) a[i] = vs_frag(vT, 16 * s + 8 * hi, 4, h * 128 + 32 * (vb0 + i), lane);
#pragma unroll
          for (int j = 0; j < 2; ++j) bb[j] = vs_frag<KD_PITCH>(kdT, 16 * s + 8 * hi, 4, h * 64 + 32 * j, lane);
#pragma unroll
          for (int i = 0; i < 2; ++i)
#pragma unroll
              for (int j = 0; j < 2; ++j) d[i][j] = __builtin_amdgcn_mfma_f32_32x32x16_bf16(a[i], bb[j], d[i][j], 0, 0, 0); }
      float* dst = (float*)(ws + WS_DST) + ((size_t)bh * 128 + n) * 8192;
#pragma unroll
      for (int j = 0; j < 2; ++j) { const float dec = decs[h * 64 + 32 * j + r32];
#pragma unroll
          for (int i = 0; i < 2; ++i)
#pragma unroll
              for (int e = 0; e < 16; ++e) dst[(32 * (vb0 + i) + crow(e, hi)) * 64 + 32 * j + r32] = d[i][j][e] * dec; } }
    __syncthreads();
}

DI void gla_scan(const Params& p, int G, LAS unsigned char* lds) {
    const float* dST = (const float*)(p.ws + WS_DST); const float* decay = (const float*)(p.ws + WS_DECAY); bf16_t* SpT = (bf16_t*)(p.ws + WS_SPT);
    LAS float* dl = (LAS float*)lds;
    const int tid = get_tid();
    for (int e0 = blockIdx.x * 512; e0 < 16 * 8192; e0 += G * 512) {
        const int e = e0 + tid, bh = e0 >> 13, vk = e & 8191, k = e & 63, b = bh >> 2, h = bh & 3;
        __syncthreads();
#pragma unroll
        for (int i4 = 0; i4 < 4; ++i4) { const int idx = tid * 4 + 2048 * i4, n = idx >> 6, kk = idx & 63;
            *(LAS f32x4*)(dl + idx) = *(const f32x4*)(decay + (size_t)(b * 128 + n) * 256 + h * 64 + kk); }
        __syncthreads();
        const float* dp = dST + (size_t)bh * 128 * 8192 + vk; bf16_t* sp = SpT + (size_t)bh * 128 * 8192 + vk;
        float st = 0.f;
        for (int n0 = 0; n0 < 128; n0 += 64) { float dv[64];
#pragma unroll
            for (int j2 = 0; j2 < 64; ++j2) dv[j2] = __builtin_nontemporal_load(dp + (size_t)(n0 + j2) * 8192);
#pragma unroll
            for (int j2 = 0; j2 < 64; ++j2) { sp[(size_t)(n0 + j2) * 8192] = f2bf(st); st = dl[(n0 + j2) * 64 + k] * st + dv[j2]; } }
    }
    __syncthreads();
}

constexpr int FX_K = 0, FX_V = 36864, FX_CK = 73728, FX_CB = 74752, FX_AL = 75264, FX_TLO = 76288, FX_KP = 72;
DI void fx_init(f32x16& p0, f32x16& p1, const LAS float* ck, float cqm, int hi) {
#pragma unroll
    for (int g = 0; g < 4; ++g) { const f32x4 c0 = *(const LAS f32x4*)(ck + 8 * g + 4 * hi), c1 = *(const LAS f32x4*)(ck + 32 + 8 * g + 4 * hi);
#pragma unroll
        for (int e = 0; e < 4; ++e) { p0[4 * g + e] = cqm - c0[e]; p1[4 * g + e] = cqm - c1[e]; } }
}
DI void fx_qk(f32x16& p0, f32x16& p1, const LAS bf16_t* Kt, const bf16x8 (&qr)[4], int r32, int hi) {
#pragma unroll
    for (int ks = 0; ks < 4; ++ks) { const bf16x8 a0 = *(const LAS bf16x8*)(Kt + r32 * 72 + 16 * ks + 8 * hi), a1 = *(const LAS bf16x8*)(Kt + (32 + r32) * 72 + 16 * ks + 8 * hi);
        p0 = __builtin_amdgcn_mfma_f32_32x32x16_bf16(a0, qr[ks], p0, 0, 0, 0); p1 = __builtin_amdgcn_mfma_f32_32x32x16_bf16(a1, qr[ks], p1, 0, 0, 0); }
}
DI void fx_vfrag(bf16x8 (&vfr)[4][2], const LAS bf16_t* Vt, int lane, int hi) {
#pragma unroll
    for (int st = 0; st < 4; ++st)
#pragma unroll
        for (int db = 0; db < 2; ++db) { const LAS bf16_t* vp = Vt + (16 * st + 4 * hi + ((lane & 15) >> 2)) * 72 + 32 * db + 16 * ((lane >> 4) & 1) + 4 * (lane & 3);
            const s16x4 lo = __builtin_bit_cast(s16x4, __builtin_amdgcn_ds_read_tr16_b64_v4i16((LAS v4i16_t*)vp));
            const s16x4 hh = __builtin_bit_cast(s16x4, __builtin_amdgcn_ds_read_tr16_b64_v4i16((LAS v4i16_t*)(vp + 8 * 72)));
            vfr[st][db] = __builtin_shufflevector(lo, hh, 0, 1, 2, 3, 4, 5, 6, 7); }
}
template <bool PEND> DI void fx_softmax(f32x16& p0, f32x16& p1, f32x16& q0, f32x16& q1, bf16x8 (&pw)[4], f32x16 (&o)[2], float& m, float& l, float& cqm, float cq, LAS float* al,
                                        int k0, int qw0, int qrow, int r32, int hi) {
    if (k0 + 63 > qw0) {
#pragma unroll
        for (int i = 0; i < 16; ++i) { const int kv = k0 + crow(i, hi); if (kv > qrow) p0[i] = -INFINITY; if (kv + 32 > qrow) p1[i] = -INFINITY; } }
    float rm = fmaxf(fmaxf(p0[0], p1[0]), fmaxf(p0[1], p1[1]));
#pragma unroll
    for (int i = 2; i < 16; i += 2) { rm = fmaxf(fmaxf(rm, p0[i]), p1[i]); rm = fmaxf(fmaxf(rm, p0[i + 1]), p1[i + 1]); }
    rm = fmaxf(rm, __shfl_xor(rm, 32));
    if (__any(rm > 0.f)) {
        const float dl = fmaxf(rm, 0.f), alpha = __builtin_amdgcn_exp2f(-dl); l *= alpha; m += dl; cqm = cq - m;
#pragma unroll
        for (int i = 0; i < 16; ++i) { p0[i] -= dl; p1[i] -= dl; }
        if (PEND) {
#pragma unroll
            for (int i = 0; i < 16; ++i) { q0[i] -= dl; q1[i] -= dl; } }
        if (hi == 0) al[r32] = alpha;
        asm volatile("s_waitcnt lgkmcnt(0)" ::: "memory");
#pragma unroll
        for (int g = 0; g < 4; ++g) { const f32x4 a4 = *(const LAS f32x4*)(al + 8 * g + 4 * hi);
#pragma unroll
            for (int e = 0; e < 4; ++e) { o[0][4 * g + e] *= a4[e]; o[1][4 * g + e] *= a4[e]; } }
        asm volatile("" ::: "memory");
    }
#pragma unroll
    for (int i = 0; i < 16; ++i) { p0[i] = __builtin_amdgcn_exp2f(p0[i]); p1[i] = __builtin_amdgcn_exp2f(p1[i]); }
    { const f32x16 t = p0 + p1; const f32x4 u4 = (f32x4){t[0], t[1], t[2], t[3]} + (f32x4){t[4], t[5], t[6], t[7]} + (f32x4){t[8], t[9], t[10], t[11]} + (f32x4){t[12], t[13], t[14], t[15]};
      l += (u4.x + u4.y) + (u4.z + u4.w); }
#pragma unroll
    for (int s2 = 0; s2 < 2; ++s2) { u32x4 w0, w1;
#pragma unroll
        for (int e = 0; e < 4; ++e) { w0[e] = pk2(p0[8 * s2 + 2 * e], p0[8 * s2 + 2 * e + 1]); w1[e] = pk2(p1[8 * s2 + 2 * e], p1[8 * s2 + 2 * e + 1]); }
        pw[s2] = __builtin_bit_cast(bf16x8, w0); pw[2 + s2] = __builtin_bit_cast(bf16x8, w1); }
}
DI void fx_pv(f32x16 (&o)[2], const bf16x8 (&pw)[4], const bf16x8 (&vfr)[4][2]) {
#pragma unroll
    for (int st = 0; st < 4; ++st)
#pragma unroll
        for (int db = 0; db < 2; ++db) o[db] = __builtin_amdgcn_mfma_f32_32x32x16_bf16(pw[st], vfr[st][db], o[db], 0, 0, 0);
}
DI void fox_bh_setup(int bh, const Params& p, LAS unsigned char* lds) {
    const int tid = get_tid(), lane = tid & 63, wid = tid >> 6;
    LAS float* cbase = (LAS float*)(lds + FX_CB);
    const float* ct = (const float*)(p.ws + WS_CTOT) + bh * 128;
    __syncthreads();
    if (wid == 0) { const float v0 = ct[2 * lane], v1 = ct[2 * lane + 1], s = v0 + v1; float incl = s;
#pragma unroll
        for (int o = 1; o < 64; o <<= 1) { const float t = __shfl_up(incl, o); if (lane >= o) incl += t; }
        const float excl = incl - s; cbase[2 * lane] = excl; cbase[2 * lane + 1] = excl + v0; }
    __syncthreads();
}
DI void fox_unit(int bh, int qb, const Params& p, LAS unsigned char* lds, float thr2) {
    const int tid = get_tid(), lane = tid & 63, wid = __builtin_amdgcn_readfirstlane(tid >> 6), r32 = lane & 31, hi = lane >> 5;
    const bf16_t* proj = (const bf16_t*)(p.ws + WS_PROJ);
    const int b = bh >> 3, h = bh & 7, q0 = qb * 256; const size_t rowbase = (size_t)b * SEQ;
    LAS bf16_t* Kb = (LAS bf16_t*)(lds + FX_K); LAS bf16_t* Vb = (LAS bf16_t*)(lds + FX_V); LAS float* ckb = (LAS float*)(lds + FX_CK); LAS float* cbase = (LAS float*)(lds + FX_CB);
    LAS float* al = (LAS float*)(lds + FX_AL) + wid * 32; LAS int* tlo = (LAS int*)(lds + FX_TLO);
    const float* cl = (const float*)(p.ws + WS_CLOC) + (size_t)bh * SEQ;
#define FX_C2(t) (cbase[(t) >> 6] + cl[(t)])
    const int T_hi = q0 / 128 + 1;
    const int krow = tid & 127, chunk = tid >> 7;
    u32x4 kreg[2], vreg[2]; float ckreg = 0.f;
#define FX_LOAD(T) do { const bf16_t* rp = proj + (rowbase + 128 * (T) + krow) * NPROJ + h * 64 + chunk * 8; \
        kreg[0] = *(const u32x4*)(rp + C_FK); kreg[1] = *(const u32x4*)(rp + C_FK + 32); vreg[0] = *(const u32x4*)(rp + C_FV); vreg[1] = *(const u32x4*)(rp + C_FV + 32); \
        if (tid < 128) ckreg = FX_C2(128 * (T) + tid); } while (0)
#define FX_STORE(buf) do { _Pragma("unroll") for (int i_ = 0; i_ < 2; ++i_) { *(LAS u32x4*)(Kb + (buf) * 9216 + krow * FX_KP + (chunk + 4 * i_) * 8) = kreg[i_]; \
            *(LAS u32x4*)(Vb + (buf) * 9216 + krow * FX_KP + (chunk + 4 * i_) * 8) = vreg[i_]; } \
        if (tid < 128) ckb[(buf) * 128 + tid] = ckreg; } while (0)
    FX_LOAD(T_hi);
    const int qw0 = q0 + 32 * wid, qrow = qw0 + r32;
    bf16x8 qr[4];
#pragma unroll
    for (int ks = 0; ks < 4; ++ks) qr[ks] = *(const bf16x8*)(proj + (rowbase + qrow) * NPROJ + C_FQ + h * 64 + 16 * ks + 8 * hi);
    if (tid == 0) *tlo = q0 / 64;
    const float cq0 = FX_C2(q0), cq = FX_C2(qrow);
    const float cend = (tid < q0 / 64) ? FX_C2(64 * tid + 63) : 0.f;
    __syncthreads();
    if (tid < q0 / 64) { if (cq0 - cend >= -thr2) atomicMin((int*)tlo, tid); }
    FX_STORE(0);
    __syncthreads();
    const int t_lo = *tlo, T_lo = t_lo >> 1;
    float m = 0.f, l = 0.f, cqm = cq; f32x16 o[2];
#pragma unroll
    for (int e = 0; e < 16; ++e) { o[0][e] = 0.f; o[1][e] = 0.f; }
    for (int T = T_hi; T >= T_lo; --T) {
        const int buf = (T_hi - T) & 1;
        if (T > T_lo) FX_LOAD(T - 1);
        { const int k1 = 128 * T + 64, k0s = 128 * T;
          const LAS float* ckT = ckb + buf * 128; const LAS bf16_t* KtT = Kb + buf * 9216; const LAS bf16_t* VtT = Vb + buf * 9216;
          const bool act1 = (k1 <= qw0 + 31) && (2 * T + 1 >= t_lo), act0 = (k0s <= qw0 + 31) && (2 * T >= t_lo);
          if (act1 && act0) {
              f32x16 a0, a1, b0, b1; bf16x8 vfr[4][2], pw[4];
              fx_init(a0, a1, ckT + 64, cqm, hi); fx_init(b0, b1, ckT, cqm, hi);
              fx_qk(a0, a1, KtT + 64 * FX_KP, qr, r32, hi);
              fx_qk(b0, b1, KtT, qr, r32, hi);
              fx_vfrag(vfr, VtT + 64 * FX_KP, lane, hi);
              __builtin_amdgcn_sched_barrier(0);
              fx_softmax<true>(a0, a1, b0, b1, pw, o, m, l, cqm, cq, al, k1, qw0, qrow, r32, hi);
              __builtin_amdgcn_sched_barrier(0);
              fx_pv(o, pw, vfr);
              fx_vfrag(vfr, VtT, lane, hi);
              __builtin_amdgcn_sched_barrier(0);
              fx_softmax<false>(b0, b1, b0, b1, pw, o, m, l, cqm, cq, al, k0s, qw0, qrow, r32, hi);
              __builtin_amdgcn_sched_barrier(0);
              fx_pv(o, pw, vfr);
          } else if (act1 || act0) {
              const int sub = act1 ? 1 : 0, k0 = 128 * T + 64 * sub;
              f32x16 p0, p1; bf16x8 vfr[4][2], pw[4];
              fx_init(p0, p1, ckT + 64 * sub, cqm, hi);
              fx_qk(p0, p1, KtT + (64 * sub) * FX_KP, qr, r32, hi);
              fx_vfrag(vfr, VtT + (64 * sub) * FX_KP, lane, hi);
              __builtin_amdgcn_sched_barrier(0);
              fx_softmax<false>(p0, p1, p0, p1, pw, o, m, l, cqm, cq, al, k0, qw0, qrow, r32, hi);
              __builtin_amdgcn_sched_barrier(0);
              fx_pv(o, pw, vfr);
          }
        }
        if (T > T_lo) FX_STORE(buf ^ 1);
        __syncthreads();
    }
    l += __shfl_xor(l, 32);
    if (hi == 0) al[r32] = 1.0f / l;
    asm volatile("s_waitcnt lgkmcnt(0)" ::: "memory");
    bf16_t* mix = (bf16_t*)(p.ws + WS_MIX);
#pragma unroll
    for (int g = 0; g < 4; ++g) { const f32x4 a4 = *(const LAS f32x4*)(al + 8 * g + 4 * hi);
#pragma unroll
        for (int e = 0; e < 4; ++e) { const int i = 4 * g + e; bf16_t* orow = mix + (rowbase + qw0 + crow(i, hi)) * DM + h * 64 + r32;
            orow[0] = f2bf(o[0][i] * a4[e]); orow[32] = f2bf(o[1][i] * a4[e]); } }
#undef FX_C2
#undef FX_LOAD
#undef FX_STORE
}

DI void gla_out_unit(int chunk, const Params& p, LAS unsigned char* lds) {
    const int tid = get_tid(), lane = tid & 63, wid = __builtin_amdgcn_readfirstlane(tid >> 6), r32 = lane & 31, hi = lane >> 5;
    const bf16_t* proj = (const bf16_t*)(p.ws + WS_PROJ);
    const int b = chunk >> 7, n = chunk & 127, tok0 = chunk * 64;
    LAS bf16_t* vT = (LAS bf16_t*)(lds + L2_VT);
    const int h = wid >> 1, cb = wid & 1, bh = b * 4 + h, tok = tok0 + 32 * cb + r32;
    bf16x8 qf[4], kf[2][4], sf[4][4];
#pragma unroll
    for (int ks = 0; ks < 4; ++ks) qf[ks] = *(const bf16x8*)(proj + (size_t)tok * NPROJ + C_GQ + h * 64 + 16 * ks + 8 * hi);
#pragma unroll
    for (int sb = 0; sb < 2; ++sb)
#pragma unroll
        for (int ks = 0; ks < 4; ++ks) kf[sb][ks] = *(const bf16x8*)(proj + (size_t)(tok0 + 32 * sb + r32) * NPROJ + C_GK + h * 64 + 16 * ks + 8 * hi);
    const bf16_t* sp = (const bf16_t*)(p.ws + WS_SPT) + ((size_t)bh * 128 + n) * 8192;
#pragma unroll
    for (int vb = 0; vb < 4; ++vb)
#pragma unroll
        for (int ks = 0; ks < 4; ++ks) sf[vb][ks] = *(const bf16x8*)(sp + (32 * vb + r32) * 64 + 16 * ks + 8 * hi);
    u32x2 gwv[4][4];
#pragma unroll
    for (int vb = 0; vb < 4; ++vb)
#pragma unroll
        for (int g = 0; g < 4; ++g) gwv[vb][g] = *(const u32x2*)(proj + (size_t)tok * NPROJ + C_GR + h * 128 + 32 * vb + 8 * g + 4 * hi);
    stage_vT(proj, tok0, lds, tid);
    __syncthreads();
    f32x16 oT[4];
#pragma unroll
    for (int vb = 0; vb < 4; ++vb)
#pragma unroll
        for (int e = 0; e < 16; ++e) oT[vb][e] = 0.f;
#pragma unroll
    for (int vb = 0; vb < 4; ++vb)
#pragma unroll
        for (int ks = 0; ks < 4; ++ks) oT[vb] = __builtin_amdgcn_mfma_f32_32x32x16_bf16(sf[vb][ks], qf[ks], oT[vb], 0, 0, 0);
#pragma unroll
    for (int sb = 0; sb < 2; ++sb) {
        if (sb <= cb) {
        f32x16 X;
#pragma unroll
        for (int e = 0; e < 16; ++e) X[e] = 0.f;
#pragma unroll
        for (int ks = 0; ks < 4; ++ks) X = __builtin_amdgcn_mfma_f32_32x32x16_bf16(kf[sb][ks], qf[ks], X, 0, 0, 0);
        if (sb == cb) {
#pragma unroll
            for (int i = 0; i < 16; ++i) if (crow(i, hi) > r32) X[i] = 0.f; }
        bf16x8 xs[2];
#pragma unroll
        for (int s2 = 0; s2 < 2; ++s2) { u32x4 w;
#pragma unroll
            for (int e = 0; e < 4; ++e) w[e] = pk2(X[8 * s2 + 2 * e], X[8 * s2 + 2 * e + 1]);
            xs[s2] = __builtin_bit_cast(bf16x8, w); }
#pragma unroll
        for (int vb = 0; vb < 4; ++vb)
#pragma unroll
            for (int st = 0; st < 2; ++st) { const bf16x8 af = vs_frag(vT, 32 * sb + 16 * st + 4 * hi, 8, h * 128 + 32 * vb, lane);
                oT[vb] = __builtin_amdgcn_mfma_f32_32x32x16_bf16(af, xs[st], oT[vb], 0, 0, 0); }
        }
    }
    float ss = 0.f;
#pragma unroll
    for (int vb = 0; vb < 4; ++vb)
#pragma unroll
        for (int e = 0; e < 16; ++e) ss += oT[vb][e] * oT[vb][e];
    ss += __shfl_xor(ss, 32);
    const float rstd = rsqrtf(ss * (1.0f / 128.0f) + EPS);
    bf16_t* mix = (bf16_t*)(p.ws + WS_MIX);
#pragma unroll
    for (int vb = 0; vb < 4; ++vb)
#pragma unroll
        for (int g = 0; g < 4; ++g) { const int v0 = 32 * vb + 8 * g + 4 * hi;
            const u32x2 gw = gwv[vb][g];
            const f32x4 gn = *(const f32x4*)(p.gla_og + h * 128 + v0);
            float r[4] = {bflo(gw.x), bfhi(gw.x), bflo(gw.y), bfhi(gw.y)}; float ov[4];
#pragma unroll
            for (int e = 0; e < 4; ++e) { const float sg = r[e] / (1.0f + __expf(-r[e])); ov[e] = oT[vb][4 * g + e] * rstd * gn[e] * sg; }
            u32x2 w; w.x = pk2(ov[0], ov[1]); w.y = pk2(ov[2], ov[3]);
            *(u32x2*)(mix + (size_t)tok * DM + 512 + h * 128 + v0) = w; }
    __syncthreads();
}

#define XB_TMO      128
#define XB_XCNT(j)  (256  + 64 * (j))
#define XB_XSUB(j)  (1280 + 64 * (j))
#define XB_XGEN(j)  (2304 + 64 * (j))
#define XB_TOP      3328
#define XB_TOPGEN   3392
#define XCD_BAR_WORDS 3456
#define XB_SPIN_CAP (1u << 18)
DI unsigned xb_ld(unsigned* p)              { return __hip_atomic_load(p, __ATOMIC_RELAXED, __HIP_MEMORY_SCOPE_AGENT); }
DI unsigned xb_add(unsigned* p, unsigned v) { return __hip_atomic_fetch_add(p, v, __ATOMIC_RELAXED, __HIP_MEMORY_SCOPE_AGENT); }
DI unsigned xb_xcc_id() { return (unsigned)__builtin_amdgcn_s_getreg((3 << 11) | 20) & 0xFu; }
#define XB_SPIN(cond, bar) do { unsigned _sp = 0; while (cond) { __builtin_amdgcn_s_sleep(1); \
    if ((++_sp & 255u) == 0u) { if (xb_ld(&(bar)[XB_TMO])) break; if (_sp > XB_SPIN_CAP) { atomicAdd(&(bar)[XB_TMO], 1u); break; } } } } while (0)
struct XcdBarrier { unsigned* bar; unsigned x; volatile LAS unsigned* st; };
DI XcdBarrier xcd_barrier_post(unsigned* bar, volatile LAS unsigned* st) {
    XcdBarrier b; b.bar = bar; b.x = xb_xcc_id(); b.st = st;
    if (threadIdx.x == 0) (void)xb_add(&bar[XB_XCNT(b.x)], 1u);
    return b;
}
DI void xcd_barrier_complete(unsigned* bar, unsigned x, unsigned& nloc, unsigned& nx) {
    const unsigned G = gridDim.x * gridDim.y * gridDim.z;
    unsigned sum, cnt, mine, sp = 0u;
    for (;;) {
        sum = 0u; cnt = 0u; mine = 0u;
#pragma unroll
        for (unsigned j = 0; j < 16; ++j) { const unsigned c = xb_ld(&bar[XB_XCNT(j)]); sum += c; cnt += (c > 0u) ? 1u : 0u; mine = (j == x) ? c : mine; }
        if (sum == G) break;
        __builtin_amdgcn_s_sleep(1);
        if ((++sp & 255u) == 0u) { if (xb_ld(&bar[XB_TMO])) break; if (sp > XB_SPIN_CAP) { atomicAdd(&bar[XB_TMO], 1u); break; } }
    }
    nloc = mine > 0u ? mine : 1u; nx = cnt > 0u ? cnt : 1u;
}
DI void xcd_barrier(const XcdBarrier& b) {
    asm volatile("s_waitcnt vmcnt(0)" ::: "memory");
    __syncthreads();
    if (threadIdx.x == 0) {
        unsigned* bar = b.bar;
        __builtin_amdgcn_s_waitcnt(0);
        unsigned nloc = b.st[0], nx = b.st[1];
        if (nloc == 0u) { xcd_barrier_complete(bar, b.x, nloc, nx); b.st[0] = nloc; b.st[1] = nx; }
        const unsigned old = xb_add(&bar[XB_XSUB(b.x)], 1u);
        const unsigned gen = old / nloc;
        if (old + 1u == (gen + 1u) * nloc) {
            __builtin_amdgcn_fence(__ATOMIC_RELEASE, "agent");
            asm volatile("s_waitcnt vmcnt(0)" ::: "memory");
            const unsigned og = xb_add(&bar[XB_TOP], 1u);
            const unsigned tg = og / nx;
            if (og + 1u == (tg + 1u) * nx) xb_add(&bar[XB_TOPGEN], 1u);
            else XB_SPIN(xb_ld(&bar[XB_TOPGEN]) == tg, bar);
            __builtin_amdgcn_fence(__ATOMIC_ACQUIRE, "agent");
            xb_add(&bar[XB_XGEN(b.x)], 1u);
            asm volatile("s_waitcnt vmcnt(0)" ::: "memory");
        } else {
            XB_SPIN(xb_ld(&bar[XB_XGEN(b.x)]) == gen, bar);
            __builtin_amdgcn_fence(__ATOMIC_ACQUIRE, "agent");
            asm volatile("s_waitcnt vmcnt(0)" ::: "memory");
        }
    }
    __syncthreads();
}

__global__ void __launch_bounds__(512, 2) fwd_megakernel(Params p) {
    extern __shared__ __attribute__((aligned(16))) unsigned char lds_raw[];
    LAS unsigned char* lds = (LAS unsigned char*)lds_raw;
    cg::grid_group grid = cg::this_grid();
    const int G = gridDim.x, bx = blockIdx.x;
    unsigned char* ws = p.ws;
    bf16_t* proj = (bf16_t*)(ws + WS_PROJ);

    if (threadIdx.x < 2) ((volatile LAS unsigned*)(lds + MISC_OFF))[threadIdx.x] = 0u;
    __syncthreads();
    if (p.never) grid.sync();
    const XcdBarrier xbar = xcd_barrier_post((unsigned*)(ws + WS_BAR), (volatile LAS unsigned*)(lds + MISC_OFF));
#define GSYNC() xcd_barrier(xbar)
    for (int rep = 0; rep < (PROBE_ID == 3 ? 2 : 1); ++rep) { p0_prologue(p, lds, G); if (PROBE_ID == 3) GSYNC(); }
    GSYNC();
    if (PROBE_ID == 1) { for (int rep = 0; rep < 10; ++rep) GSYNC(); }
    for (int rep10 = 0; rep10 < (PROBE_ID == 10 ? 2 : 1); ++rep10) {
    for (int rep = 0; rep < (PROBE_ID == 2 ? 2 : 1); ++rep) {
    { pg8::Gemm g{(const bf16_t*)(ws + WS_XN), (const bf16_t*)(ws + WS_WIN)};
      pg8::StaticOrder S; S.init(MTOK, NPROJ, G, bx);
      pg8::EpiProj E{proj, (float*)(ws + WS_AUX), p.fox_q_g, p.fox_k_g};
      pg8::gemm_phase<pg8::GeoPlain<DM>>(lds, g, S, E); }
    { pg8::Gemm g{(const bf16_t*)(ws + WS_MEMN), (const bf16_t*)(ws + WS_WKV)};
      pg8::StaticOrder S; S.init(NBATCH * MEMLEN, 2 * DM, G, (bx + G / 2) % G);
      pg8::EpiNorm E{(bf16_t*)(ws + WS_KN), nullptr, p.xk_g, 1.0f, (bf16_t*)(ws + WS_VT)};
      pg8::gemm_phase<pg8::GeoPlain<DM>>(lds, g, S, E); }
    if (G == 256 && bx >= 160) { __syncthreads(); late_transposes(p, lds, (bx - 160) * 8 + (int)(threadIdx.x >> 6), (G - 160) * 8); }
    if (PROBE_ID == 2 && rep == 0) GSYNC(); }
    GSYNC();
    for (int c = bx; c < MTOK / 64; c += G) p2_unit(c, p, lds);
    GSYNC();
    }
    for (int rep = 0; rep < (PROBE_ID == 4 ? 2 : 1); ++rep) {
    { pg8::Gemm g{(const bf16_t*)(ws + WS_WO), (const bf16_t*)(ws + WS_VT)};
      pg8::StaticOrder S; S.init(DM, 4 * DM, G, (G == 256) ? ((((bx >> 3) & 7) <= 1) ? ((bx & 7) + 8 * ((bx >> 3) & 7) + 16 * (bx >> 6)) : 64 + bx) : bx);
      pg8::EpiBf<4 * DM, 0, false, -1> E{(bf16_t*)(ws + WS_VWT), nullptr, nullptr};
      pg8::gemm_phase<pg8::Geo<256, DM, DM, 256, 256, 0, 0, 2, 256L * DM>>(lds, g, S, E); }
    for (int r11 = 0; r11 < (PROBE_ID == 11 ? 2 : 1); ++r11) gla_scan(p, G, lds);
    { const int tl = get_tid() & 63; float gq = fabsf(p.fox_q_g[tl]), gk = fabsf(p.fox_k_g[tl]);
#pragma unroll
      for (int o = 1; o < 64; o <<= 1) { gq = fmaxf(gq, __shfl_xor(gq, o)); gk = fmaxf(gk, __shfl_xor(gk, o)); }
      const float bqk = 64.0f * gq * gk * 0.125f * LOG2E * 1.02f, thr2 = 150.0f + bqk;
      if (G == 256) { const int bh = (bx & 7) * 4 + (bx >> 6), j = (bx >> 3) & 7;
          fox_bh_setup(bh, p, lds);
          for (int i = 3; i >= 0; --i) fox_unit(bh, j + 8 * i, p, lds, thr2); }
      else { for (int u = bx; u < 1024; u += G) { fox_bh_setup(u >> 5, p, lds); fox_unit(u >> 5, u & 31, p, lds, thr2); } } }
    if (PROBE_ID == 4 && rep == 0) GSYNC(); }
    GSYNC();
    for (int rep = 0; rep < (PROBE_ID == 5 ? 2 : 1); ++rep) {
    for (int c = bx; c < MTOK / 64; c += G) gla_out_unit(c, p, lds);
    if (PROBE_ID == 5 && rep == 0) GSYNC(); }
    GSYNC();
    { pg8::Gemm g{(const bf16_t*)(ws + WS_MIX), (const bf16_t*)(ws + WS_WOUT)};
      pg8::StaticOrder S; S.init(MTOK, DM, G, bx);
      pg8::EpiRes<false, false, true> E{p.x, nullptr, (bf16_t*)(ws + WS_HB), (float*)(ws + WS_SUMSQ1)};
      pg8::gemm_phase<pg8::GeoPlain<DM>>(lds, g, S, E); }
    GSYNC();
    for (int rep = 0; rep < (PROBE_ID == 6 ? 2 : 1); ++rep) {
    { pg8::Gemm g{(const bf16_t*)(ws + WS_HB), (const bf16_t*)(ws + WS_WQ)};
      pg8::StaticOrder S; S.init(MTOK, DM, G, bx);
      pg8::EpiNorm E{(bf16_t*)(ws + WS_QN), (const float*)(ws + WS_SUMSQ1), p.xq_g, 1.0f / 16.0f, nullptr};
      pg8::gemm_phase<pg8::GeoPlain<DM>>(lds, g, S, E); }
    if (PROBE_ID == 6 && rep == 0) GSYNC(); }
    GSYNC();
    for (int rep = 0; rep < (PROBE_ID == 7 ? 2 : 1); ++rep) {
    { pg8::Gemm g{(const bf16_t*)(ws + WS_QN), (const bf16_t*)(ws + WS_KN)};
      pg8::StaticOrder S; S.init(MTOK, DM, G, bx);
      pg8::EpiSoftmax E{(bf16_t*)(ws + WS_P)};
      pg8::gemm_phase<pg8::Geo<256, DM, DM, 256, 256, 256L * DM, 5>>(lds, g, S, E); }
    if (PROBE_ID == 7 && rep == 0) GSYNC(); }
    GSYNC();
    { pg8::Gemm g{(const bf16_t*)(ws + WS_P), (const bf16_t*)(ws + WS_VWT)};
      pg8::StaticOrder S; S.init(MTOK, DM, G, bx);
      pg8::EpiRes<true, false, true> E{(const void*)(ws + WS_HB), nullptr, (bf16_t*)(ws + WS_HB), (float*)(ws + WS_SUMSQ2)};
      pg8::gemm_phase<pg8::Geo<DM, DM, 4 * DM, 0, 256L * 4 * DM, DM, 5>>(lds, g, S, E); }
    GSYNC();
    for (int rep = 0; rep < (PROBE_ID == 9 ? 2 : 1); ++rep) {
    { pg8::Gemm g{(const bf16_t*)(ws + WS_HB), (const bf16_t*)(ws + WS_W1)};
      pg8::StaticOrder S; S.init(MTOK, FF, G, bx);
      pg8::EpiBf<FF, 1, true, -1> E{(bf16_t*)(ws + WS_U), (const float*)(ws + WS_SUMSQ2), nullptr};
      pg8::gemm_phase<pg8::GeoPlain<DM>>(lds, g, S, E); }
    if (PROBE_ID == 9 && rep == 0) GSYNC(); }
    GSYNC();
    { pg8::Gemm g{(const bf16_t*)(ws + WS_U), (const bf16_t*)(ws + WS_W2)};
      pg8::StaticOrder S; S.init(MTOK, DM, G, bx);
      pg8::EpiRes<true, true, false> E{(const void*)(ws + WS_HB), p.out, nullptr, nullptr};
      pg8::gemm_phase<pg8::GeoPlain<FF>>(lds, g, S, E); }
}

extern "C" void kernel_launch(void* const* d_in, const int* in_sizes, int n_in, void* d_out, int out_size, void* d_ws, size_t ws_size, hipStream_t stream) {
    static int grid = 0;
    if (grid == 0) {
        int dev = 0, cus = 0, per_cu = 0;
        hipGetDevice(&dev);
        hipDeviceGetAttribute(&cus, hipDeviceAttributeMultiprocessorCount, dev);
        hipFuncSetAttribute((const void*)fwd_megakernel, hipFuncAttributeMaxDynamicSharedMemorySize, LDS_BYTES);
        hipOccupancyMaxActiveBlocksPerMultiprocessor(&per_cu, (const void*)fwd_megakernel, 512, LDS_BYTES);
        if (per_cu < 1) { fprintf(stderr, "kernel_launch: occupancy query reports %d blocks per CU\n", per_cu); per_cu = 1; }
        if (per_cu > 1) per_cu = 1;
        grid = cus * per_cu;
        if (ws_size < WS_END) { fprintf(stderr, "kernel_launch: workspace too small (%zu < %zu)\n", ws_size, (size_t)WS_END); grid = -1; }
    }
    if (grid < 0) return;
    Params p{};
    const float** pp = (const float**)&p;
    for (int i = 0; i < 21; ++i) pp[i] = (const float*)d_in[i];
    p.out = (float*)d_out; p.ws = (unsigned char*)d_ws;
    p.never = 0;
    if (hipMemsetAsync((char*)d_ws + WS_BAR, 0, XCD_BAR_WORDS * 4, stream) != hipSuccess) { fprintf(stderr, "kernel_launch: memset of the barrier words failed\n"); return; }
    void* args[] = {&p};
    hipError_t e = hipLaunchCooperativeKernel((const void*)fwd_megakernel, dim3(grid), dim3(512), args, LDS_BYTES, stream);
    if (e != hipSuccess) fprintf(stderr, "cooperative launch failed: %s (grid %d)\n", hipGetErrorString(e), grid);
}
```

```cpp
#define PROBE_ID 0
#include <hip/hip_runtime.h>
#include <hip/hip_cooperative_groups.h>
#include <cstdio>
#include <cstdint>
namespace cg = cooperative_groups;

#define LAS __attribute__((address_space(3)))
#define DI __device__ __forceinline__
typedef unsigned short bf16_t;
typedef short bf16x8 __attribute__((ext_vector_type(8)));
typedef short s16x4 __attribute__((ext_vector_type(4)));
typedef float f32x4 __attribute__((ext_vector_type(4)));
typedef float f32x2 __attribute__((ext_vector_type(2)));
typedef float f32x16 __attribute__((ext_vector_type(16)));
typedef unsigned u32x4 __attribute__((ext_vector_type(4)));
typedef unsigned u32x2 __attribute__((ext_vector_type(2)));
typedef __bf16 bf16x2_t __attribute__((ext_vector_type(2)));
typedef short v4i16_t __attribute__((ext_vector_type(4)));

DI unsigned pk2(float lo, float hi) { f32x2 v = {lo, hi}; bf16x2_t b = __builtin_convertvector(v, bf16x2_t); return __builtin_bit_cast(unsigned, b); }
DI float bf2f(bf16_t u) { return __uint_as_float(((unsigned)u) << 16); }
DI float bflo(unsigned w) { return __uint_as_float(w << 16); }
DI float bfhi(unsigned w) { return __uint_as_float(w & 0xffff0000u); }
DI bf16_t f2bf(float f) { return (bf16_t)(pk2(f, 0.f) & 0xffffu); }
DI int get_tid() { int t = threadIdx.x; asm volatile("" : "+v"(t)); return t; }
DI int crow(int r, int hi) { return (r & 3) + 8 * (r >> 2) + 4 * hi; }
#define BAR_LDS() do { asm volatile("s_waitcnt lgkmcnt(0)" ::: "memory"); __builtin_amdgcn_s_barrier(); asm volatile("" ::: "memory"); } while (0)

constexpr int DM = 1024, NBATCH = 4, SEQ = 8192, MTOK = NBATCH * SEQ, NPROJ = 3328, FF = 4096, MEMLEN = 256;
constexpr int C_FQ = 0, C_FK = 512, C_FV = 1024, C_GQ = 1536, C_GK = 1792, C_GV = 2048, C_GR = 2560;
constexpr float EPS = 1e-6f, LOG2E = 1.4426950408889634f;
constexpr int RED_OFF = 131072;
constexpr int MISC_OFF = 131072 + 8192;
constexpr int LDS_BYTES = 131072 + 8192 + 1024;

namespace pg8 {
constexpr int BM = 256, BK = 64, HALF = 128, HTB = HALF * BK * 2, STAGE_BYTES = 8 * HTB, NXCD = 8, WGM = 4;
__host__ __device__ __forceinline__ int lds_byte(int r, int c) { const int st = (r >> 4) * 2 + (c >> 5), rr = r & 15, cc = c & 31, ob = rr * 64 + cc * 2; return st * 1024 + (ob ^ (((ob >> 9) & 1) << 5)); }
__host__ __device__ __forceinline__ void stage_rc(int b, int& R, int& C) { const int st = b / 1024, sb = b % 1024, swz = sb ^ (((sb >> 9) & 1) << 5); R = (st >> 1) * 16 + swz / 64; C = (st & 1) * 32 + (swz % 64) / 2; }
__host__ __device__ __forceinline__ int perm32(int rho) { const int n = rho >> 4, i = rho & 15; return 8 * (i >> 2) + 4 * n + (i & 3); }

struct Unit { int pm, pn; };
struct Gemm { const bf16_t* A; const bf16_t* Bt; };
template <int K_, int LDA_, int LDB_, long APN_, long BPN_, long BBATCH_, int BSHIFT_, int PNBITS_ = 30, long BPNHI_ = 0> struct Geo { static constexpr int K = K_, LDA = LDA_, LDB = LDB_, BSHIFT = BSHIFT_, PNBITS = PNBITS_; static constexpr long APN = APN_, BPN = BPN_, BBATCH = BBATCH_, BPNHI = BPNHI_; };
template <int K_> using GeoPlain = Geo<K_, K_, K_, 0, 256L * K_, 0, 0>;

struct StaticOrder {
    int nM, nN, nwg, G, c;
    __host__ __device__ void init(int M, int N, int G_, int c_) { nM = M / BM; nN = N / BM; nwg = nM * nN; G = G_; c = c_; }
    __host__ __device__ bool next(int i, Unit& u) const {
        const long L = (long)i * G + c; if (L >= nwg) return false;
        int wgid = (int)L; { const int q = nwg / NXCD, r = nwg % NXCD, xcd = wgid % NXCD, off = wgid / NXCD; wgid = (xcd < r ? xcd * (q + 1) : r * (q + 1) + (xcd - r) * q) + off; }
        const int nig = WGM * nN, gid = wgid / nig, fm = gid * WGM, gsz = (nM - fm) < WGM ? (nM - fm) : WGM;
        u.pm = fm + ((wgid % nig) % gsz); u.pn = (wgid % nig) / gsz; return true;
    }
};

typedef f32x4 Acc[2][2][4][2];

template <bool ISMAX> DI void tile_row_reduce(float (&p)[2][4], LAS float* red, int wr, int wc, int fr, int fq) {
#pragma unroll
    for (int ai = 0; ai < 2; ++ai)
#pragma unroll
        for (int m = 0; m < 4; ++m) { float v = p[ai][m]; const float a = __shfl_xor(v, 16); v = ISMAX ? fmaxf(v, a) : v + a; const float b = __shfl_xor(v, 32); v = ISMAX ? fmaxf(v, b) : v + b;
            if (fq == 0) red[(ai * 128 + wr * 64 + m * 16 + fr) * 4 + wc] = v; }
    BAR_LDS();
#pragma unroll
    for (int ai = 0; ai < 2; ++ai)
#pragma unroll
        for (int m = 0; m < 4; ++m) { const f32x4 q = *(const LAS f32x4*)(red + (ai * 128 + wr * 64 + m * 16 + fr) * 4);
            p[ai][m] = ISMAX ? fmaxf(fmaxf(q.x, q.y), fmaxf(q.z, q.w)) : (q.x + q.y) + (q.z + q.w); }
}

template <bool BASE_BF16, bool OUT_F32, bool OUT_BF16> struct EpiRes {
    static constexpr bool PERM = true;
    const void* base; float* out; bf16_t* hb; float* sumsq;
    DI void operator()(Acc& acc, const Unit& u, int wr, int wc, int fr, int fq, LAS unsigned char* lds) const {
        const int col0 = u.pn * BM + wc * 32 + 8 * fq;
        float part[2][4];
#pragma unroll
        for (int ai = 0; ai < 2; ++ai)
#pragma unroll
            for (int m = 0; m < 4; ++m) { const int row = u.pm * BM + ai * HALF + wr * 64 + m * 16 + fr; const size_t off = (size_t)row * DM + col0; float ss = 0.f;
#pragma unroll
                for (int bj = 0; bj < 2; ++bj) { const size_t o = off + bj * HALF;
                    f32x4 b0, b1;
                    if (BASE_BF16) { const u32x4 w = *(const u32x4*)((const bf16_t*)base + o); b0 = (f32x4){bflo(w.x), bfhi(w.x), bflo(w.y), bfhi(w.y)}; b1 = (f32x4){bflo(w.z), bfhi(w.z), bflo(w.w), bfhi(w.w)}; }
                    else { b0 = *(const f32x4*)((const float*)base + o); b1 = *(const f32x4*)((const float*)base + o + 4); }
                    const f32x4 v0 = b0 + acc[ai][bj][m][0], v1 = b1 + acc[ai][bj][m][1];
                    if (OUT_F32) { __builtin_nontemporal_store(v0, (f32x4*)(out + o)); __builtin_nontemporal_store(v1, (f32x4*)(out + o + 4)); }
                    if (OUT_BF16) { u32x4 w; w.x = pk2(v0.x, v0.y); w.y = pk2(v0.z, v0.w); w.z = pk2(v1.x, v1.y); w.w = pk2(v1.z, v1.w); *(u32x4*)(hb + o) = w;
                        ss += ((v0.x * v0.x + v0.y * v0.y) + (v0.z * v0.z + v0.w * v0.w)) + ((v1.x * v1.x + v1.y * v1.y) + (v1.z * v1.z + v1.w * v1.w)); } }
                part[ai][m] = ss; }
        if (OUT_BF16) {
            tile_row_reduce<false>(part, (LAS float*)(lds + RED_OFF), wr, wc, fr, fq);
            if (wc == 0 && fq == 0) {
#pragma unroll
                for (int ai = 0; ai < 2; ++ai)
#pragma unroll
                    for (int m = 0; m < 4; ++m) sumsq[(size_t)(u.pm * BM + ai * HALF + wr * 64 + m * 16 + fr) * 4 + u.pn] = part[ai][m]; }
        }
    }
};
template <int ldc, int act, bool HAS_RS, int aux_pn> struct EpiBf {
    static constexpr bool PERM = true;
    bf16_t* O; const float* sumsq; float* aux;
    DI void operator()(Acc& acc, const Unit& u, int wr, int wc, int fr, int fq, LAS unsigned char*) const {
        if (aux_pn >= 0 && u.pn == aux_pn) {
            if (wc == 0) {
#pragma unroll
                for (int ai = 0; ai < 2; ++ai)
#pragma unroll
                    for (int m = 0; m < 4; ++m) { const int row = u.pm * BM + ai * HALF + wr * 64 + m * 16 + fr;
#pragma unroll
                        for (int n = 0; n < 2; ++n) *(f32x4*)(aux + (size_t)row * 32 + 8 * fq + 4 * n) = acc[ai][0][m][n]; } }
            return; }
        const int col0 = u.pn * BM + wc * 32 + 8 * fq;
#pragma unroll
        for (int ai = 0; ai < 2; ++ai)
#pragma unroll
            for (int m = 0; m < 4; ++m) { const int row = u.pm * BM + ai * HALF + wr * 64 + m * 16 + fr; bf16_t* rowp = O + (size_t)row * ldc + col0;
                float rs = 1.0f; if (HAS_RS) { const f32x4 q4 = *(const f32x4*)(sumsq + (size_t)row * 4); rs = rsqrtf(((q4.x + q4.y) + (q4.z + q4.w)) * (1.0f / DM) + EPS); }
#pragma unroll
                for (int bj = 0; bj < 2; ++bj) { f32x4 v0 = acc[ai][bj][m][0] * rs, v1 = acc[ai][bj][m][1] * rs;
                    if (act) { v0 = __builtin_elementwise_max(v0, (f32x4){0.f, 0.f, 0.f, 0.f}); v1 = __builtin_elementwise_max(v1, (f32x4){0.f, 0.f, 0.f, 0.f}); v0 = v0 * v0; v1 = v1 * v1; }
                    u32x4 w; w.x = pk2(v0.x, v0.y); w.y = pk2(v0.z, v0.w); w.z = pk2(v1.x, v1.y); w.w = pk2(v1.z, v1.w);
                    if (act) __builtin_nontemporal_store(w, (u32x4*)(rowp + bj * HALF)); else *(u32x4*)(rowp + bj * HALF) = w; } }
    }
};
struct EpiProj {
    static constexpr bool PERM = true;
    bf16_t* O; float* aux; const float* gq; const float* gk;
    DI void operator()(Acc& acc, const Unit& u, int wr, int wc, int fr, int fq, LAS unsigned char* lds) const {
        if (u.pn == 12) {
            if (wc == 0) {
#pragma unroll
                for (int ai = 0; ai < 2; ++ai)
#pragma unroll
                    for (int m = 0; m < 4; ++m) { const int row = u.pm * BM + ai * HALF + wr * 64 + m * 16 + fr;
#pragma unroll
                        for (int n = 0; n < 2; ++n) *(f32x4*)(aux + (size_t)row * 32 + 8 * fq + 4 * n) = acc[ai][0][m][n]; } }
            return; }
        const int col0 = u.pn * BM + wc * 32 + 8 * fq;
        if (u.pn < 4) {
            LAS float* red = (LAS float*)(lds + RED_OFF);
#pragma unroll
            for (int ai = 0; ai < 2; ++ai)
#pragma unroll
                for (int m = 0; m < 4; ++m)
#pragma unroll
                    for (int bj = 0; bj < 2; ++bj) { const f32x4 v0 = acc[ai][bj][m][0], v1 = acc[ai][bj][m][1];
                        float ss = ((v0.x * v0.x + v0.y * v0.y) + (v0.z * v0.z + v0.w * v0.w)) + ((v1.x * v1.x + v1.y * v1.y) + (v1.z * v1.z + v1.w * v1.w));
                        ss += __shfl_xor(ss, 16); ss += __shfl_xor(ss, 32);
                        if (fq == 0) red[(ai * 128 + wr * 64 + m * 16 + fr) * 8 + bj * 4 + wc] = ss; }
            BAR_LDS();
            const bool isk = u.pn >= 2; const float* g = (isk ? gk : gq) + 32 * (wc & 1) + 8 * fq; const float sc = isk ? 1.0f : 0.125f * LOG2E;
            const f32x4 g0 = *(const f32x4*)g, g1 = *(const f32x4*)(g + 4);
#pragma unroll
            for (int ai = 0; ai < 2; ++ai)
#pragma unroll
                for (int m = 0; m < 4; ++m) { const int rl = ai * HALF + wr * 64 + m * 16 + fr; bf16_t* rowp = O + (size_t)(u.pm * BM + rl) * NPROJ + col0;
#pragma unroll
                    for (int bj = 0; bj < 2; ++bj) { const f32x2 pr = *(const LAS f32x2*)(red + rl * 8 + bj * 4 + (wc & 2)); const float tot = pr.x + pr.y; const float rs = rsqrtf(tot * (1.0f / 64.0f) + EPS) * sc;
                        const f32x4 v0 = acc[ai][bj][m][0] * rs * g0, v1 = acc[ai][bj][m][1] * rs * g1;
                        u32x4 w; w.x = pk2(v0.x, v0.y); w.y = pk2(v0.z, v0.w); w.z = pk2(v1.x, v1.y); w.w = pk2(v1.z, v1.w); *(u32x4*)(rowp + bj * HALF) = w; } }
            return; }
#pragma unroll
        for (int ai = 0; ai < 2; ++ai)
#pragma unroll
            for (int m = 0; m < 4; ++m) { const int row = u.pm * BM + ai * HALF + wr * 64 + m * 16 + fr; bf16_t* rowp = O + (size_t)row * NPROJ + col0;
#pragma unroll
                for (int bj = 0; bj < 2; ++bj) { const f32x4 v0 = acc[ai][bj][m][0], v1 = acc[ai][bj][m][1];
                    u32x4 w; w.x = pk2(v0.x, v0.y); w.y = pk2(v0.z, v0.w); w.z = pk2(v1.x, v1.y); w.w = pk2(v1.z, v1.w); *(u32x4*)(rowp + bj * HALF) = w; } }
    }
};
struct EpiNorm {
    static constexpr bool PERM = true;
    bf16_t* O; const float* sumsq; const float* gain; float scale; bf16_t* vt;
    DI void operator()(Acc& acc, const Unit& u, int wr, int wc, int fr, int fq, LAS unsigned char* lds) const {
        if (vt && u.pn >= 4) {
#pragma unroll
            for (int ai = 0; ai < 2; ++ai)
#pragma unroll
                for (int m = 0; m < 4; ++m) { const int row = u.pm * BM + ai * HALF + wr * 64 + m * 16 + fr; bf16_t* rowp = vt + (size_t)row * DM + (u.pn - 4) * BM + wc * 32 + 8 * fq;
#pragma unroll
                    for (int bj = 0; bj < 2; ++bj) { const f32x4 v0 = acc[ai][bj][m][0], v1 = acc[ai][bj][m][1];
                        u32x4 w; w.x = pk2(v0.x, v0.y); w.y = pk2(v0.z, v0.w); w.z = pk2(v1.x, v1.y); w.w = pk2(v1.z, v1.w); *(u32x4*)(rowp + bj * HALF) = w; } }
            return; }
        LAS float* red = (LAS float*)(lds + RED_OFF);
        float part[2][4];
#pragma unroll
        for (int ai = 0; ai < 2; ++ai)
#pragma unroll
            for (int m = 0; m < 4; ++m) { const int row = u.pm * BM + ai * HALF + wr * 64 + m * 16 + fr;
                float rs = 1.0f; if (sumsq) { const f32x4 q4 = *(const f32x4*)(sumsq + (size_t)row * 4); rs = rsqrtf(((q4.x + q4.y) + (q4.z + q4.w)) * (1.0f / DM) + EPS); } float ss = 0.f;
#pragma unroll
                for (int bj = 0; bj < 2; ++bj)
#pragma unroll
                    for (int n = 0; n < 2; ++n) { const f32x4 v = acc[ai][bj][m][n] * rs; acc[ai][bj][m][n] = v; ss += (v.x * v.x + v.y * v.y) + (v.z * v.z + v.w * v.w); }
                part[ai][m] = ss; }
        tile_row_reduce<false>(part, red, wr, wc, fr, fq);
        const int cin = wc * 32 + 8 * fq;
#pragma unroll
        for (int ai = 0; ai < 2; ++ai)
#pragma unroll
            for (int m = 0; m < 4; ++m) { const int row = u.pm * BM + ai * HALF + wr * 64 + m * 16 + fr; const float rn = rsqrtf(part[ai][m] * (1.0f / 256.0f) + EPS) * scale;
                bf16_t* rowp = O + (size_t)row * DM + u.pn * BM + cin;
#pragma unroll
                for (int bj = 0; bj < 2; ++bj) { const f32x4 g0 = *(const f32x4*)(gain + bj * HALF + cin), g1 = *(const f32x4*)(gain + bj * HALF + cin + 4);
                    const f32x4 v0 = acc[ai][bj][m][0] * rn * g0, v1 = acc[ai][bj][m][1] * rn * g1;
                    u32x4 w; w.x = pk2(v0.x, v0.y); w.y = pk2(v0.z, v0.w); w.z = pk2(v1.x, v1.y); w.w = pk2(v1.z, v1.w); __builtin_nontemporal_store(w, (u32x4*)(rowp + bj * HALF)); } }
    }
};
struct EpiSoftmax {
    static constexpr bool PERM = true;
    bf16_t* O;
    DI void operator()(Acc& acc, const Unit& u, int wr, int wc, int fr, int fq, LAS unsigned char* lds) const {
        LAS float* red = (LAS float*)(lds + RED_OFF);
        float part[2][4];
#pragma unroll
        for (int ai = 0; ai < 2; ++ai)
#pragma unroll
            for (int m = 0; m < 4; ++m) { float mx = -3.0e38f;
#pragma unroll
                for (int bj = 0; bj < 2; ++bj)
#pragma unroll
                    for (int n = 0; n < 2; ++n) { const f32x4 v = acc[ai][bj][m][n]; mx = fmaxf(mx, fmaxf(fmaxf(v.x, v.y), fmaxf(v.z, v.w))); }
                part[ai][m] = mx; }
        tile_row_reduce<true>(part, red, wr, wc, fr, fq);
        float part2[2][4];
#pragma unroll
        for (int ai = 0; ai < 2; ++ai)
#pragma unroll
            for (int m = 0; m < 4; ++m) { const float mx = part[ai][m] * LOG2E; float s = 0.f;
#pragma unroll
                for (int bj = 0; bj < 2; ++bj)
#pragma unroll
                    for (int n = 0; n < 2; ++n) { f32x4 v = acc[ai][bj][m][n];
#pragma unroll
                        for (int e = 0; e < 4; ++e) { v[e] = __builtin_amdgcn_exp2f(v[e] * LOG2E - mx); s += v[e]; }
                        acc[ai][bj][m][n] = v; }
                part2[ai][m] = s; }
        tile_row_reduce<false>(part2, red + 1024, wr, wc, fr, fq);
        const int cin = wc * 32 + 8 * fq;
#pragma unroll
        for (int ai = 0; ai < 2; ++ai)
#pragma unroll
            for (int m = 0; m < 4; ++m) { const int row = u.pm * BM + ai * HALF + wr * 64 + m * 16 + fr; const float inv = 1.0f / part2[ai][m];
                bf16_t* rowp = O + (size_t)row * DM + u.pn * BM + cin;
#pragma unroll
                for (int bj = 0; bj < 2; ++bj) { const f32x4 v0 = acc[ai][bj][m][0] * inv, v1 = acc[ai][bj][m][1] * inv;
                    u32x4 w; w.x = pk2(v0.x, v0.y); w.y = pk2(v0.z, v0.w); w.z = pk2(v1.x, v1.y); w.w = pk2(v1.z, v1.w); *(u32x4*)(rowp + bj * HALF) = w; } }
    }
};

template <class GEO, class Epi>
__device__ __forceinline__ void gemm_phase(LAS unsigned char* lds, const Gemm g, const StaticOrder& S, const Epi& E) {
    const int tid = get_tid(), wid = __builtin_amdgcn_readfirstlane(tid >> 6), lane = tid & 63, wr = wid >> 2, wc = wid & 3, fr = lane & 15, fq = lane >> 4;
    constexpr int K = GEO::K, nt = K / BK;
    unsigned voffA[2], voffB[2];
#pragma unroll
    for (int i = 0; i < 2; ++i) { int R, C; stage_rc(tid * 16 + i * 8192, R, C); const int Rb = Epi::PERM ? ((R & ~31) + perm32(R & 31)) : R;
        voffA[i] = (unsigned)(R * GEO::LDA + C) * 2u; voffB[i] = (unsigned)(Rb * GEO::LDB + C) * 2u; }
    const size_t kstep = (size_t)(BK * 2);
    constexpr size_t hstepA = (size_t)HALF * GEO::LDA * 2, hstepB = (size_t)HALF * GEO::LDB * 2;
    const unsigned ldsw = (unsigned)wid * 1024u;
    const int aoff = lds_byte(wr * 64 + fr, fq * 8), boff = lds_byte(wc * 32 + fr, fq * 8);
#define PG8_SA(b, h) (((b) * 2 + (h)) * HTB)
#define PG8_SB(b, h) ((4 + (b) * 2 + (h)) * HTB)
#define PG8_STAGE(bufoff, gbase, voff) do { _Pragma("unroll") for (int _i = 0; _i < 2; ++_i) \
        __builtin_amdgcn_global_load_lds((const unsigned*)((const char*)(gbase) + (voff)[_i]), (LAS unsigned*)(lds + (bufoff) + ldsw + _i * 8192), 16, 0, 0); } while (0)
#define PG8_LDA(dst, b, h) do { _Pragma("unroll") for (int m = 0; m < 4; ++m) _Pragma("unroll") for (int k = 0; k < 2; ++k) dst[m][k] = *(const LAS bf16x8*)(lds + PG8_SA(b, h) + aoff + m * 2048 + k * 1024); } while (0)
#define PG8_LDB(dst, b, h) do { _Pragma("unroll") for (int n = 0; n < 2; ++n) _Pragma("unroll") for (int k = 0; k < 2; ++k) dst[n][k] = *(const LAS bf16x8*)(lds + PG8_SB(b, h) + boff + n * 2048 + k * 1024); } while (0)
#define PG8_MMA(ai, bj, At, Bt) do { __builtin_amdgcn_s_setprio(1); _Pragma("unroll") for (int m = 0; m < 4; ++m) _Pragma("unroll") for (int n = 0; n < 2; ++n) _Pragma("unroll") for (int k = 0; k < 2; ++k) \
        acc[ai][bj][m][n] = __builtin_amdgcn_mfma_f32_16x16x32_bf16(Bt[n][k], At[m][k], acc[ai][bj][m][n], 0, 0, 0); __builtin_amdgcn_s_setprio(0); } while (0)
#define PG8_WAIT_V(n) asm volatile("s_waitcnt vmcnt(" #n ")" ::: "memory")
#define PG8_WAIT_L(n) asm volatile("s_waitcnt lgkmcnt(" #n ")" ::: "memory")
#define PG8_BAR __builtin_amdgcn_s_barrier()
#define PG8_SCHED __builtin_amdgcn_sched_barrier(0)
#define PG8_APTR(u) ((const char*)g.A + ((size_t)(u).pm * BM * GEO::LDA + (size_t)((u).pn & ((1 << GEO::PNBITS) - 1)) * GEO::APN) * 2)
#define PG8_BPTR(u) ((const char*)g.Bt + ((size_t)((u).pn & ((1 << GEO::PNBITS) - 1)) * GEO::BPN + (size_t)((u).pn >> GEO::PNBITS) * GEO::BPNHI + (size_t)((u).pm >> GEO::BSHIFT) * GEO::BBATCH) * 2)
    Unit cur, nxt; int ui = 0;
    if (!S.next(0, cur)) return;
    Acc acc;
#pragma unroll
    for (int a = 0; a < 2; ++a)
#pragma unroll
        for (int b = 0; b < 2; ++b)
#pragma unroll
            for (int m = 0; m < 4; ++m)
#pragma unroll
                for (int n = 0; n < 2; ++n) acc[a][b][m][n] = (f32x4){0.f, 0.f, 0.f, 0.f};
    bf16x8 At[4][2], B0[2][2], B1[2][2];
    const char* cA = PG8_APTR(cur); const char* cB = PG8_BPTR(cur);
    PG8_STAGE(PG8_SB(0, 0), cB, voffB); PG8_STAGE(PG8_SB(0, 1), cB + hstepB, voffB); PG8_STAGE(PG8_SA(0, 0), cA, voffA); PG8_STAGE(PG8_SA(0, 1), cA + hstepA, voffA);
    if (wr == 1) PG8_BAR;
    PG8_WAIT_V(2); PG8_BAR;
    PG8_STAGE(PG8_SB(1, 0), cB + kstep, voffB); PG8_STAGE(PG8_SA(1, 0), cA + kstep, voffA); PG8_STAGE(PG8_SB(1, 1), cB + hstepB + kstep, voffB);
    PG8_WAIT_V(6); PG8_BAR;
    for (;;) {
        const bool has_next = S.next(ui + 1, nxt);
        const char* nA = has_next ? PG8_APTR(nxt) : cA; const char* nB = has_next ? PG8_BPTR(nxt) : cB;
#pragma nounroll
        for (int t = 0; t < nt; t += 2) {
            const bool last = (t == nt - 2);
            const char* a1 = cA + (size_t)(t + 1) * kstep;
            const char* a2 = last ? nA : cA + (size_t)(t + 2) * kstep; const char* b2 = last ? nB : cB + (size_t)(t + 2) * kstep;
            const char* a3 = a2 + kstep; const char* b3 = b2 + kstep;
            PG8_LDB(B0, 0, 0); PG8_LDB(B1, 0, 1); PG8_SCHED; PG8_LDA(At, 0, 0); PG8_STAGE(PG8_SA(1, 1), a1 + hstepA, voffA);
            PG8_WAIT_V(8); PG8_WAIT_L(0); PG8_BAR; PG8_MMA(0, 0, At, B0); PG8_MMA(0, 1, At, B1); PG8_BAR; PG8_SCHED;
            PG8_LDA(At, 0, 1); PG8_STAGE(PG8_SB(0, 0), b2, voffB); PG8_STAGE(PG8_SB(0, 1), b2 + hstepB, voffB); PG8_STAGE(PG8_SA(0, 0), a2, voffA);
            PG8_WAIT_V(8); PG8_WAIT_L(0); PG8_BAR; PG8_MMA(1, 0, At, B0); PG8_MMA(1, 1, At, B1); PG8_BAR; PG8_SCHED;
            PG8_LDB(B0, 1, 0); PG8_LDB(B1, 1, 1); PG8_SCHED; PG8_LDA(At, 1, 0); PG8_STAGE(PG8_SA(0, 1), a2 + hstepA, voffA);
            PG8_WAIT_V(8); PG8_WAIT_L(0); PG8_BAR; PG8_MMA(0, 0, At, B0); PG8_MMA(0, 1, At, B1); PG8_BAR; PG8_SCHED;
            PG8_LDA(At, 1, 1); PG8_STAGE(PG8_SB(1, 0), b3, voffB); PG8_STAGE(PG8_SB(1, 1), b3 + hstepB, voffB); PG8_STAGE(PG8_SA(1, 0), a3, voffA);
            PG8_WAIT_V(8); PG8_WAIT_L(0); PG8_BAR; PG8_MMA(1, 0, At, B0); PG8_MMA(1, 1, At, B1); PG8_BAR; PG8_SCHED;
        }
        if (wr == 0) PG8_BAR;
        E(acc, cur, wr, wc, fr, fq, lds);
        if (!has_next) break;
#pragma unroll
        for (int a = 0; a < 2; ++a)
#pragma unroll
            for (int b = 0; b < 2; ++b)
#pragma unroll
                for (int m = 0; m < 4; ++m)
#pragma unroll
                    for (int n = 0; n < 2; ++n) acc[a][b][m][n] = (f32x4){0.f, 0.f, 0.f, 0.f};
        cur = nxt; cA = nA; cB = nB; ++ui;
        if (wr == 1) PG8_BAR;
    }
    PG8_WAIT_V(0);
    PG8_BAR;
#undef PG8_SA
#undef PG8_SB
#undef PG8_STAGE
#undef PG8_LDA
#undef PG8_LDB
#undef PG8_MMA
#undef PG8_WAIT_V
#undef PG8_WAIT_L
#undef PG8_BAR
#undef PG8_SCHED
#undef PG8_APTR
#undef PG8_BPTR
}
}

constexpr size_t MiB = 1u << 20;
constexpr size_t WS_SUMSQ1 = 0, WS_SUMSQ2 = 1024 * 1024, WS_BAR = 512 * 1024;
constexpr size_t WS_WIN = 2 * MiB, WS_WOUT = 9 * MiB, WS_WQ = 11 * MiB, WS_WKV = 13 * MiB, WS_WO = 17 * MiB, WS_W1 = 19 * MiB, WS_W2 = 27 * MiB;
constexpr size_t WS_MEMN = 36 * MiB, WS_KN = 38 * MiB, WS_VT = 40 * MiB, WS_AUX = 42 * MiB;
constexpr size_t WS_CLOC = 46 * MiB, WS_CTOT = 47 * MiB, WS_DECAY = 47 * MiB + 65536;
constexpr size_t WS_XN = 48 * MiB, WS_DST = 48 * MiB, WS_U = 48 * MiB;
constexpr size_t WS_PROJ = 112 * MiB, WS_QN = 112 * MiB, WS_P = 176 * MiB;
constexpr size_t WS_VWT = 480 * MiB;
constexpr size_t WS_SPT = 320 * MiB, WS_MIX = 352 * MiB, WS_HB = 416 * MiB, WS_END = 488 * MiB;

struct Params {
    const float *x, *mem, *norm_mix_g, *w_in, *fox_b_f, *fox_q_g, *fox_k_g, *gla_w2, *gla_bg, *gla_og, *w_out, *norm_x_g, *norm_mem_g, *wq, *wkv, *xq_g, *xk_g, *wo, *norm_mlp_g, *w1, *w2;
    float* out; unsigned char* ws;
    long never;
};

DI float wave_sum(float v) {
#pragma unroll
    for (int o = 1; o < 64; o <<= 1) v += __shfl_xor(v, o);
    return v;
}
DI float logsig(float z) { return fminf(z, 0.f) - log1pf(expf(-fabsf(z))); }
DI float logsig_fast(float z) { return fminf(z, 0.f) - __logf(1.0f + __expf(-fabsf(z))); }

DI void p0_transpose_item(const float* W, int ldw, int src0, int K, bf16_t* WT, int dst0, const float* gain, LAS float* scr, int kb, int nb, int lane) {
    const int k0 = 64 * kb, n0 = 32 * nb, kr = lane >> 3, c4 = lane & 7;
    f32x4 v[8];
#pragma unroll
    for (int i = 0; i < 8; ++i) v[i] = __builtin_nontemporal_load((const f32x4*)(W + (size_t)(k0 + kr + 8 * i) * ldw + src0 + n0 + 4 * c4));
#pragma unroll
    for (int i = 0; i < 8; ++i) { const float g = gain ? gain[k0 + kr + 8 * i] : 1.0f; LAS float* d = scr + (kr + 8 * i) * 33 + 4 * c4; d[0] = v[i].x * g; d[1] = v[i].y * g; d[2] = v[i].z * g; d[3] = v[i].w * g; }
    asm volatile("s_waitcnt lgkmcnt(0)" ::: "memory");
    const int c = lane & 7;
#pragma unroll
    for (int j = 0; j < 4; ++j) { const int n = (lane >> 3) + 8 * j; const LAS float* s = scr + (8 * c) * 33 + n;
        u32x4 o; o.x = pk2(s[0 * 33], s[1 * 33]); o.y = pk2(s[2 * 33], s[3 * 33]); o.z = pk2(s[4 * 33], s[5 * 33]); o.w = pk2(s[6 * 33], s[7 * 33]);
        *(u32x4*)(WT + (size_t)(dst0 + n0 + n) * K + k0 + 8 * c) = o; }
    asm volatile("s_waitcnt lgkmcnt(0)" ::: "memory");
}
template <int NR> DI void rms_rows_load(f32x4 (&v)[NR][4], const float* xrow, int lane) {
#pragma unroll
    for (int r = 0; r < NR; ++r) { const f32x4* xr = (const f32x4*)(xrow + (size_t)r * DM) + lane;
#pragma unroll
        for (int j = 0; j < 4; ++j) v[r][j] = __builtin_nontemporal_load(xr + 64 * j); }
}
template <int NR> DI void rms_rows_store(const f32x4 (&v)[NR][4], const float* g, bf16_t* orow, int lane) {
    float s[NR];
#pragma unroll
    for (int r = 0; r < NR; ++r) { float a = 0.f;
#pragma unroll
        for (int j = 0; j < 4; ++j) a += (v[r][j].x * v[r][j].x + v[r][j].y * v[r][j].y) + (v[r][j].z * v[r][j].z + v[r][j].w * v[r][j].w);
        s[r] = a; }
#pragma unroll
    for (int o = 1; o < 64; o <<= 1)
#pragma unroll
        for (int r = 0; r < NR; ++r) s[r] += __shfl_xor(s[r], o);
    const f32x4* gr = (const f32x4*)g + lane;
#pragma unroll
    for (int j = 0; j < 4; ++j) { const f32x4 gg = gr[64 * j];
#pragma unroll
        for (int r = 0; r < NR; ++r) { const float rstd = rsqrtf(s[r] * (1.f / DM) + EPS); u32x2 w; w.x = pk2(v[r][j].x * rstd * gg.x, v[r][j].y * rstd * gg.y); w.y = pk2(v[r][j].z * rstd * gg.z, v[r][j].w * rstd * gg.w);
            ((u32x2*)(orow + (size_t)r * DM) + lane)[64 * j] = w; } }
}
DI void late_transposes(const Params& p, LAS unsigned char* lds, int gwv, int ngw) {
    const int tid = get_tid(), lane = tid & 63, wave = tid >> 6;
    unsigned char* ws = p.ws;
    LAS float* scr = (LAS float*)(lds + wave * 16384);
    constexpr int J3 = 16 * 32, J4 = 16 * 32, J6 = 16 * 32, J7 = 16 * 128, J8 = 64 * 32;
    for (int it = gwv; it < J3 + J4 + J6 + J7 + J8; it += ngw) {
        int r = it;
        if (r < J3) { p0_transpose_item(p.w_out, DM, 0, DM, (bf16_t*)(ws + WS_WOUT), 0, nullptr, scr, r / 32, r % 32, lane); continue; } r -= J3;
        if (r < J4) { p0_transpose_item(p.wq, DM, 0, DM, (bf16_t*)(ws + WS_WQ), 0, p.norm_x_g, scr, r / 32, r % 32, lane); continue; } r -= J4;
        if (r < J6) { p0_transpose_item(p.wo, DM, 0, DM, (bf16_t*)(ws + WS_WO), 0, nullptr, scr, r / 32, r % 32, lane); continue; } r -= J6;
        if (r < J7) { p0_transpose_item(p.w1, FF, 0, DM, (bf16_t*)(ws + WS_W1), 0, p.norm_mlp_g, scr, r / 128, r % 128, lane); continue; } r -= J7;
        p0_transpose_item(p.w2, DM, 0, FF, (bf16_t*)(ws + WS_W2), 0, nullptr, scr, r / 32, r % 32, lane);
    }
}
DI void p0_prologue(const Params& p, LAS unsigned char* lds, int G) {
    const int tid = get_tid(), lane = tid & 63, wave = tid >> 6;
    unsigned char* ws = p.ws;
    LAS float* scr = (LAS float*)(lds + wave * 16384);
    const int gw = blockIdx.x * 8 + wave, NGW = G * 8;
    constexpr int I0 = 16 * 48, I1 = 16 * 32, I2 = 16 * 16, I3 = 16 * 32, I4 = 16 * 32, I5 = 16 * 64, I6 = 16 * 32, I7 = 16 * 128, I8 = 64 * 32;
    constexpr int NITEMS = I0 + I1 + I2 + I3 + I4 + I5 + I6 + I7 + I8;
    const int wu = __builtin_amdgcn_readfirstlane(wave);
    for (int ph = 0; ph < 2; ++ph) {
    if (((ph ^ wu) & 1) == 1) {
    for (int r16 = 0; r16 < (PROBE_ID == 16 ? 2 : 1); ++r16) {
    for (int it = gw; it < I0 + I1 + I2 + I5; it += NGW) {
        int r = it;
        if (r < I0) { p0_transpose_item(p.w_in, 3096, 0, DM, (bf16_t*)(ws + WS_WIN), 0, nullptr, scr, r / 48, r % 48, lane); continue; } r -= I0;
        if (r < I1) { p0_transpose_item(p.w_in, 3096, 1544, DM, (bf16_t*)(ws + WS_WIN), 1536, nullptr, scr, r / 32, r % 32, lane); continue; } r -= I1;
        if (r < I2) { p0_transpose_item(p.w_in, 3096, 2584, DM, (bf16_t*)(ws + WS_WIN), 2560, nullptr, scr, r / 16, r % 16, lane); continue; } r -= I2;
        p0_transpose_item(p.wkv, 2 * DM, 0, DM, (bf16_t*)(ws + WS_WKV), 0, nullptr, scr, r / 64, r % 64, lane);
    }
    }
    } else {
    for (int r15 = 0; r15 < (PROBE_ID == 15 ? 2 : 1); ++r15)
    { f32x4 va[4][4], vb[4][4];
      int m = gw * 4;
      if (m < MTOK) rms_rows_load<4>(va, p.x + (size_t)m * DM, lane);
      for (; m < MTOK; m += NGW * 8) {
          const int m1 = m + NGW * 4, m2 = m + NGW * 8;
          if (m1 < MTOK) rms_rows_load<4>(vb, p.x + (size_t)m1 * DM, lane);
          rms_rows_store<4>(va, p.norm_mix_g, (bf16_t*)(ws + WS_XN) + (size_t)m * DM, lane);
          if (m2 < MTOK) rms_rows_load<4>(va, p.x + (size_t)m2 * DM, lane);
          if (m1 < MTOK) rms_rows_store<4>(vb, p.norm_mix_g, (bf16_t*)(ws + WS_XN) + (size_t)m1 * DM, lane);
      } }
    }
    }
    if (G != 256) late_transposes(p, lds, gw, NGW);
    { bf16_t* wt = (bf16_t*)(ws + WS_WIN) + (size_t)3072 * DM;
      for (int idx = blockIdx.x * 512 + tid; idx < 256 * DM; idx += G * 512) { const int r = idx >> 10, k = idx & 1023; float w = 0.f;
          if (r < 8) w = p.w_in[(size_t)k * 3096 + 1536 + r]; else if (r < 24) w = p.w_in[(size_t)k * 3096 + 2568 + (r - 8)];
          wt[idx] = f2bf(w); } }
    for (int m = gw; m < NBATCH * MEMLEN; m += NGW) { f32x4 v1[1][4]; rms_rows_load<1>(v1, p.mem + (size_t)m * DM, lane); rms_rows_store<1>(v1, p.norm_mem_g, (bf16_t*)(ws + WS_MEMN) + (size_t)m * DM, lane); }
}

constexpr int VT_PITCH = 72;
constexpr int L2_VT = 0, L2_KDT = 73728, L2_AUX = 110592, L2_DEC = 118784;
constexpr int VS_PITCH = 544;
DI void stage_vT(const bf16_t* proj, int tok0, LAS unsigned char* lds, int tid) {
    LAS bf16_t* vS = (LAS bf16_t*)(lds + L2_VT);
    u32x4 w[8];
#pragma unroll
    for (int i8 = 0; i8 < 8; ++i8) { const int piece = tid + 512 * i8, row = piece >> 6, cp = piece & 63; w[i8] = *(const u32x4*)(proj + (size_t)(tok0 + row) * NPROJ + C_GV + cp * 8); }
#pragma unroll
    for (int i8 = 0; i8 < 8; ++i8) { const int piece = tid + 512 * i8, row = piece >> 6, cp = piece & 63; *(LAS u32x4*)(vS + row * VS_PITCH + cp * 8) = w[i8]; }
}
template <int PITCH = VS_PITCH> DI bf16x8 vs_frag(const LAS bf16_t* vS, int row0, int rstep, int col0, int lane) {
    const LAS bf16_t* vp = vS + (row0 + ((lane & 15) >> 2)) * PITCH + col0 + 16 * ((lane >> 4) & 1) + 4 * (lane & 3);
    const s16x4 lo = __builtin_bit_cast(s16x4, __builtin_amdgcn_ds_read_tr16_b64_v4i16((LAS v4i16_t*)vp));
    const s16x4 hh = __builtin_bit_cast(s16x4, __builtin_amdgcn_ds_read_tr16_b64_v4i16((LAS v4i16_t*)(vp + rstep * PITCH)));
    return __builtin_shufflevector(lo, hh, 0, 1, 2, 3, 4, 5, 6, 7);
}
constexpr int KD_PITCH = 288;
DI void p2_unit(int chunk, const Params& p, LAS unsigned char* lds) {
    const int tid = get_tid(), lane = tid & 63, wid = __builtin_amdgcn_readfirstlane(tid >> 6), r32 = lane & 31, hi = lane >> 5;
    unsigned char* ws = p.ws;
    bf16_t* proj = (bf16_t*)(ws + WS_PROJ); const float* aux = (const float*)(ws + WS_AUX);
    const int b = chunk >> 7, n = chunk & 127, tok0 = chunk * 64;
    LAS bf16_t* vT = (LAS bf16_t*)(lds + L2_VT); LAS bf16_t* kdT = (LAS bf16_t*)(lds + L2_KDT); LAS float* auxs = (LAS float*)(lds + L2_AUX); LAS float* decs = (LAS float*)(lds + L2_DEC);
    stage_vT(proj, tok0, lds, tid);
    if (wid >= 4) { const int wj = wid - 4;
#pragma unroll
        for (int hh = 0; hh < 2; ++hh) { const int h = 2 * wj + hh;
            float v = logsig(aux[(size_t)(tok0 + lane) * 32 + h] + p.fox_b_f[h]) * LOG2E;
#pragma unroll
            for (int o = 1; o < 64; o <<= 1) { const float t = __shfl_up(v, o); if (lane >= o) v += t; }
            ((float*)(ws + WS_CLOC))[(size_t)(b * 8 + h) * SEQ + n * 64 + lane] = v;
            if (lane == 63) ((float*)(ws + WS_CTOT))[(b * 8 + h) * 128 + n] = v; } }
    { const int col = tid & 255, half = tid >> 8, t0 = 32 * half, t0u = __builtin_amdgcn_readfirstlane(t0);
      LAS float* tots = (LAS float*)(lds + L2_DEC) + 256;
      float w2c[16];
#pragma unroll
      for (int r = 0; r < 16; ++r) w2c[r] = p.gla_w2[r * 256 + col];
      const float bgc = p.gla_bg[col];
      bf16_t* pq = proj + (size_t)(tok0 + t0) * NPROJ + C_GQ + col; bf16_t* pk = proj + (size_t)(tok0 + t0) * NPROJ + C_GK + col;
      bf16_t qv32[32], kv32[32];
#pragma unroll
      for (int j2 = 0; j2 < 32; ++j2) { qv32[j2] = pq[(size_t)j2 * NPROJ]; kv32[j2] = pk[(size_t)j2 * NPROJ]; }
      float lc[32]; float bc = 0.f;
#pragma unroll
      for (int j2 = 0; j2 < 32; ++j2) { const f32x4* ar = (const f32x4*)(aux + (size_t)(tok0 + t0u + j2) * 32 + 8);
          float z = bgc;
#pragma unroll
          for (int r4 = 0; r4 < 4; ++r4) { const f32x4 a = ar[r4]; z += a.x * w2c[4 * r4] + a.y * w2c[4 * r4 + 1] + a.z * w2c[4 * r4 + 2] + a.w * w2c[4 * r4 + 3]; }
          bc += logsig_fast(z) * (1.0f / 16.0f); lc[j2] = bc; }
      if (half == 0) tots[col] = bc;
      __syncthreads();
      const float offs = half ? tots[col] : 0.f;
#pragma unroll
      for (int j2 = 0; j2 < 32; ++j2) { const float bcl = (offs + lc[j2]) * LOG2E;
          const float qd = bf2f(qv32[j2]) * 0.125f * __builtin_amdgcn_exp2f(bcl), kd = bf2f(kv32[j2]) * __builtin_amdgcn_exp2f(-bcl);
          const bf16_t kdb = f2bf(kd);
          pq[(size_t)j2 * NPROJ] = f2bf(qd); pk[(size_t)j2 * NPROJ] = kdb; kdT[(t0 + j2) * KD_PITCH + col] = kdb; }
      if (half) { const float dec = __builtin_amdgcn_exp2f((offs + bc) * LOG2E); decs[col] = dec; ((float*)(ws + WS_DECAY))[(size_t)(b * 128 + n) * 256 + col] = dec; }
    }
    __syncthreads();
    { const int h = wid >> 1, vb0 = (wid & 1) * 2, bh = b * 4 + h;
      f32x16 d[2][2];
#pragma unroll
      for (int i = 0; i < 2; ++i)
#pragma unroll
          for (int j = 0; j < 2; ++j)
#pragma unroll
              for (int e = 0; e < 16; ++e) d[i][j][e] = 0.f;
#pragma unroll
      for (int s = 0; s < 4; ++s) { bf16x8 a[2], bb[2];
#pragma unroll
          for (int i = 0; i < 2; ++i) a[i] = vs_frag(vT, 16 * s + 8 * hi, 4, h * 128 + 32 * (vb0 + i), lane);
#pragma unroll
          for (int j = 0; j < 2; ++j) bb[j] = vs_frag<KD_PITCH>(kdT, 16 * s + 8 * hi, 4, h * 64 + 32 * j, lane);
#pragma unroll
          for (int i = 0; i < 2; ++i)
#pragma unroll
              for (int j = 0; j < 2; ++j) d[i][j] = __builtin_amdgcn_mfma_f32_32x32x16_bf16(a[i], bb[j], d[i][j], 0, 0, 0); }
      float* dst = (float*)(ws + WS_DST) + ((size_t)bh * 128 + n) * 8192;
#pragma unroll
      for (int j = 0; j < 2; ++j) { const float dec = decs[h * 64 + 32 * j + r32];
#pragma unroll
          for (int i = 0; i < 2; ++i)
#pragma unroll
              for (int e = 0; e < 16; ++e) __builtin_nontemporal_store(d[i][j][e] * dec, dst + (32 * (vb0 + i) + crow(e, hi)) * 64 + 32 * j + r32); } }
    __syncthreads();
}

DI void gla_scan(const Params& p, int G, LAS unsigned char* lds) {
    const float* dST = (const float*)(p.ws + WS_DST); const float* decay = (const float*)(p.ws + WS_DECAY); bf16_t* SpT = (bf16_t*)(p.ws + WS_SPT);
    LAS float* dl = (LAS float*)lds;
    const int tid = get_tid();
    for (int e0 = blockIdx.x * 512; e0 < 16 * 8192; e0 += G * 512) {
        const int e = e0 + tid, bh = e0 >> 13, vk = e & 8191, k = e & 63, b = bh >> 2, h = bh & 3;
        __syncthreads();
#pragma unroll
        for (int i4 = 0; i4 < 4; ++i4) { const int idx = tid * 4 + 2048 * i4, n = idx >> 6, kk = idx & 63;
            *(LAS f32x4*)(dl + idx) = *(const f32x4*)(decay + (size_t)(b * 128 + n) * 256 + h * 64 + kk); }
        __syncthreads();
        const float* dp = dST + (size_t)bh * 128 * 8192 + vk; bf16_t* sp = SpT + (size_t)bh * 128 * 8192 + vk;
        float st = 0.f;
        for (int n0 = 0; n0 < 128; n0 += 64) { float dv[64];
#pragma unroll
            for (int j2 = 0; j2 < 64; ++j2) dv[j2] = __builtin_nontemporal_load(dp + (size_t)(n0 + j2) * 8192);
#pragma unroll
            for (int j2 = 0; j2 < 64; ++j2) { sp[(size_t)(n0 + j2) * 8192] = f2bf(st); st = dl[(n0 + j2) * 64 + k] * st + dv[j2]; } }
    }
    __syncthreads();
}

constexpr int FX_K = 0, FX_V = 36864, FX_CK = 73728, FX_CB = 74752, FX_AL = 75264, FX_TLO = 76288, FX_KP = 72;
DI void fx_init(f32x16& p0, f32x16& p1, const LAS float* ck, float cqm, int hi) {
#pragma unroll
    for (int g = 0; g < 4; ++g) { const f32x4 c0 = *(const LAS f32x4*)(ck + 8 * g + 4 * hi), c1 = *(const LAS f32x4*)(ck + 32 + 8 * g + 4 * hi);
#pragma unroll
        for (int e = 0; e < 4; ++e) { p0[4 * g + e] = cqm - c0[e]; p1[4 * g + e] = cqm - c1[e]; } }
}
DI void fx_qk(f32x16& p0, f32x16& p1, const LAS bf16_t* Kt, const bf16x8 (&qr)[4], int r32, int hi) {
#pragma unroll
    for (int ks = 0; ks < 4; ++ks) { const bf16x8 a0 = *(const LAS bf16x8*)(Kt + r32 * 72 + 16 * ks + 8 * hi), a1 = *(const LAS bf16x8*)(Kt + (32 + r32) * 72 + 16 * ks + 8 * hi);
        p0 = __builtin_amdgcn_mfma_f32_32x32x16_bf16(a0, qr[ks], p0, 0, 0, 0); p1 = __builtin_amdgcn_mfma_f32_32x32x16_bf16(a1, qr[ks], p1, 0, 0, 0); }
}
DI void fx_vfrag(bf16x8 (&vfr)[4][2], const LAS bf16_t* Vt, int lane, int hi) {
#pragma unroll
    for (int st = 0; st < 4; ++st)
#pragma unroll
        for (int db = 0; db < 2; ++db) { const LAS bf16_t* vp = Vt + (16 * st + 4 * hi + ((lane & 15) >> 2)) * 72 + 32 * db + 16 * ((lane >> 4) & 1) + 4 * (lane & 3);
            const s16x4 lo = __builtin_bit_cast(s16x4, __builtin_amdgcn_ds_read_tr16_b64_v4i16((LAS v4i16_t*)vp));
            const s16x4 hh = __builtin_bit_cast(s16x4, __builtin_amdgcn_ds_read_tr16_b64_v4i16((LAS v4i16_t*)(vp + 8 * 72)));
            vfr[st][db] = __builtin_shufflevector(lo, hh, 0, 1, 2, 3, 4, 5, 6, 7); }
}
template <bool PEND> DI void fx_softmax(f32x16& p0, f32x16& p1, f32x16& q0, f32x16& q1, bf16x8 (&pw)[4], f32x16 (&o)[2], float& m, float& l, float& cqm, float cq, LAS float* al,
                                        int k0, int qw0, int qrow, int r32, int hi) {
    if (k0 + 63 > qw0) {
#pragma unroll
        for (int i = 0; i < 16; ++i) { const int kv = k0 + crow(i, hi); if (kv > qrow) p0[i] = -INFINITY; if (kv + 32 > qrow) p1[i] = -INFINITY; } }
    float rm = fmaxf(fmaxf(p0[0], p1[0]), fmaxf(p0[1], p1[1]));
#pragma unroll
    for (int i = 2; i < 16; i += 2) { rm = fmaxf(fmaxf(rm, p0[i]), p1[i]); rm = fmaxf(fmaxf(rm, p0[i + 1]), p1[i + 1]); }
    rm = fmaxf(rm, __shfl_xor(rm, 32));
    if (__any(rm > 0.f)) {
        const float dl = fmaxf(rm, 0.f), alpha = __builtin_amdgcn_exp2f(-dl); l *= alpha; m += dl; cqm = cq - m;
#pragma unroll
        for (int i = 0; i < 16; ++i) { p0[i] -= dl; p1[i] -= dl; }
        if (PEND) {
#pragma unroll
            for (int i = 0; i < 16; ++i) { q0[i] -= dl; q1[i] -= dl; } }
        if (hi == 0) al[r32] = alpha;
        asm volatile("s_waitcnt lgkmcnt(0)" ::: "memory");
#pragma unroll
        for (int g = 0; g < 4; ++g) { const f32x4 a4 = *(const LAS f32x4*)(al + 8 * g + 4 * hi);
#pragma unroll
            for (int e = 0; e < 4; ++e) { o[0][4 * g + e] *= a4[e]; o[1][4 * g + e] *= a4[e]; } }
        asm volatile("" ::: "memory");
    }
#pragma unroll
    for (int i = 0; i < 16; ++i) { p0[i] = __builtin_amdgcn_exp2f(p0[i]); p1[i] = __builtin_amdgcn_exp2f(p1[i]); }
    { const f32x16 t = p0 + p1; const f32x4 u4 = (f32x4){t[0], t[1], t[2], t[3]} + (f32x4){t[4], t[5], t[6], t[7]} + (f32x4){t[8], t[9], t[10], t[11]} + (f32x4){t[12], t[13], t[14], t[15]};
      l += (u4.x + u4.y) + (u4.z + u4.w); }
#pragma unroll
    for (int s2 = 0; s2 < 2; ++s2) { u32x4 w0, w1;
#pragma unroll
        for (int e = 0; e < 4; ++e) { w0[e] = pk2(p0[8 * s2 + 2 * e], p0[8 * s2 + 2 * e + 1]); w1[e] = pk2(p1[8 * s2 + 2 * e], p1[8 * s2 + 2 * e + 1]); }
        pw[s2] = __builtin_bit_cast(bf16x8, w0); pw[2 + s2] = __builtin_bit_cast(bf16x8, w1); }
}
DI void fx_pv(f32x16 (&o)[2], const bf16x8 (&pw)[4], const bf16x8 (&vfr)[4][2]) {
#pragma unroll
    for (int st = 0; st < 4; ++st)
#pragma unroll
        for (int db = 0; db < 2; ++db) o[db] = __builtin_amdgcn_mfma_f32_32x32x16_bf16(pw[st], vfr[st][db], o[db], 0, 0, 0);
}
DI void fox_bh_setup(int bh, const Params& p, LAS unsigned char* lds) {
    const int tid = get_tid(), lane = tid & 63, wid = tid >> 6;
    LAS float* cbase = (LAS float*)(lds + FX_CB);
    const float* ct = (const float*)(p.ws + WS_CTOT) + bh * 128;
    __syncthreads();
    if (wid == 0) { const float v0 = ct[2 * lane], v1 = ct[2 * lane + 1], s = v0 + v1; float incl = s;
#pragma unroll
        for (int o = 1; o < 64; o <<= 1) { const float t = __shfl_up(incl, o); if (lane >= o) incl += t; }
        const float excl = incl - s; cbase[2 * lane] = excl; cbase[2 * lane + 1] = excl + v0; }
    __syncthreads();
}
DI void fox_unit(int bh, int qb, const Params& p, LAS unsigned char* lds, float thr2) {
    const int tid = get_tid(), lane = tid & 63, wid = __builtin_amdgcn_readfirstlane(tid >> 6), r32 = lane & 31, hi = lane >> 5;
    const bf16_t* proj = (const bf16_t*)(p.ws + WS_PROJ);
    const int b = bh >> 3, h = bh & 7, q0 = qb * 256; const size_t rowbase = (size_t)b * SEQ;
    LAS bf16_t* Kb = (LAS bf16_t*)(lds + FX_K); LAS bf16_t* Vb = (LAS bf16_t*)(lds + FX_V); LAS float* ckb = (LAS float*)(lds + FX_CK); LAS float* cbase = (LAS float*)(lds + FX_CB);
    LAS float* al = (LAS float*)(lds + FX_AL) + wid * 32; LAS int* tlo = (LAS int*)(lds + FX_TLO);
    const float* cl = (const float*)(p.ws + WS_CLOC) + (size_t)bh * SEQ;
#define FX_C2(t) (cbase[(t) >> 6] + cl[(t)])
    const int T_hi = q0 / 128 + 1;
    const int krow = tid & 127, chunk = tid >> 7;
    u32x4 kreg[2], vreg[2]; float ckreg = 0.f;
#define FX_LOAD(T) do { const bf16_t* rp = proj + (rowbase + 128 * (T) + krow) * NPROJ + h * 64 + chunk * 8; \
        kreg[0] = *(const u32x4*)(rp + C_FK); kreg[1] = *(const u32x4*)(rp + C_FK + 32); vreg[0] = *(const u32x4*)(rp + C_FV); vreg[1] = *(const u32x4*)(rp + C_FV + 32); \
        if (tid < 128) ckreg = FX_C2(128 * (T) + tid); } while (0)
#define FX_STORE(buf) do { _Pragma("unroll") for (int i_ = 0; i_ < 2; ++i_) { *(LAS u32x4*)(Kb + (buf) * 9216 + krow * FX_KP + (chunk + 4 * i_) * 8) = kreg[i_]; \
            *(LAS u32x4*)(Vb + (buf) * 9216 + krow * FX_KP + (chunk + 4 * i_) * 8) = vreg[i_]; } \
        if (tid < 128) ckb[(buf) * 128 + tid] = ckreg; } while (0)
    FX_LOAD(T_hi);
    const int qw0 = q0 + 32 * wid, qrow = qw0 + r32;
    bf16x8 qr[4];
#pragma unroll
    for (int ks = 0; ks < 4; ++ks) qr[ks] = *(const bf16x8*)(proj + (rowbase + qrow) * NPROJ + C_FQ + h * 64 + 16 * ks + 8 * hi);
    if (tid == 0) *tlo = q0 / 64;
    const float cq0 = FX_C2(q0), cq = FX_C2(qrow);
    const float cend = (tid < q0 / 64) ? FX_C2(64 * tid + 63) : 0.f;
    __syncthreads();
    if (tid < q0 / 64) { if (cq0 - cend >= -thr2) atomicMin((int*)tlo, tid); }
    FX_STORE(0);
    __syncthreads();
    const int t_lo = *tlo, T_lo = t_lo >> 1;
    float m = 0.f, l = 0.f, cqm = cq; f32x16 o[2];
#pragma unroll
    for (int e = 0; e < 16; ++e) { o[0][e] = 0.f; o[1][e] = 0.f; }
    for (int T = T_hi; T >= T_lo; --T) {
        const int buf = (T_hi - T) & 1;
        if (T > T_lo) FX_LOAD(T - 1);
        { const int k1 = 128 * T + 64, k0s = 128 * T;
          const LAS float* ckT = ckb + buf * 128; const LAS bf16_t* KtT = Kb + buf * 9216; const LAS bf16_t* VtT = Vb + buf * 9216;
          const bool act1 = (k1 <= qw0 + 31) && (2 * T + 1 >= t_lo), act0 = (k0s <= qw0 + 31) && (2 * T >= t_lo);
          if (act1 && act0) {
              f32x16 a0, a1, b0, b1; bf16x8 vfr[4][2], pw[4];
              fx_init(a0, a1, ckT + 64, cqm, hi); fx_init(b0, b1, ckT, cqm, hi);
              fx_qk(a0, a1, KtT + 64 * FX_KP, qr, r32, hi);
              fx_qk(b0, b1, KtT, qr, r32, hi);
              fx_vfrag(vfr, VtT + 64 * FX_KP, lane, hi);
              __builtin_amdgcn_sched_barrier(0);
              fx_softmax<true>(a0, a1, b0, b1, pw, o, m, l, cqm, cq, al, k1, qw0, qrow, r32, hi);
              __builtin_amdgcn_sched_barrier(0);
              fx_pv(o, pw, vfr);
              fx_vfrag(vfr, VtT, lane, hi);
              __builtin_amdgcn_sched_barrier(0);
              fx_softmax<false>(b0, b1, b0, b1, pw, o, m, l, cqm, cq, al, k0s, qw0, qrow, r32, hi);
              __builtin_amdgcn_sched_barrier(0);
              fx_pv(o, pw, vfr);
          } else if (act1 || act0) {
              const int sub = act1 ? 1 : 0, k0 = 128 * T + 64 * sub;
              f32x16 p0, p1; bf16x8 vfr[4][2], pw[4];
              fx_init(p0, p1, ckT + 64 * sub, cqm, hi);
              fx_qk(p0, p1, KtT + (64 * sub) * FX_KP, qr, r32, hi);
              fx_vfrag(vfr, VtT + (64 * sub) * FX_KP, lane, hi);
              __builtin_amdgcn_sched_barrier(0);
              fx_softmax<false>(p0, p1, p0, p1, pw, o, m, l, cqm, cq, al, k0, qw0, qrow, r32, hi);
              __builtin_amdgcn_sched_barrier(0);
              fx_pv(o, pw, vfr);
          }
        }
        if (T > T_lo) FX_STORE(buf ^ 1);
        __syncthreads();
    }
    l += __shfl_xor(l, 32);
    if (hi == 0) al[r32] = 1.0f / l;
    asm volatile("s_waitcnt lgkmcnt(0)" ::: "memory");
    bf16_t* mix = (bf16_t*)(p.ws + WS_MIX);
#pragma unroll
    for (int g = 0; g < 4; ++g) { const f32x4 a4 = *(const LAS f32x4*)(al + 8 * g + 4 * hi);
#pragma unroll
        for (int e = 0; e < 4; ++e) { const int i = 4 * g + e; bf16_t* orow = mix + (rowbase + qw0 + crow(i, hi)) * DM + h * 64 + r32;
            orow[0] = f2bf(o[0][i] * a4[e]); orow[32] = f2bf(o[1][i] * a4[e]); } }
#undef FX_C2
#undef FX_LOAD
#undef FX_STORE
}

DI void gla_out_unit(int chunk, const Params& p, LAS unsigned char* lds) {
    const int tid = get_tid(), lane = tid & 63, wid = __builtin_amdgcn_readfirstlane(tid >> 6), r32 = lane & 31, hi = lane >> 5;
    const bf16_t* proj = (const bf16_t*)(p.ws + WS_PROJ);
    const int b = chunk >> 7, n = chunk & 127, tok0 = chunk * 64;
    LAS bf16_t* vT = (LAS bf16_t*)(lds + L2_VT);
    const int h = wid >> 1, cb = wid & 1, bh = b * 4 + h, tok = tok0 + 32 * cb + r32;
    bf16x8 qf[4], kf[2][4], sf[4][4];
#pragma unroll
    for (int ks = 0; ks < 4; ++ks) qf[ks] = *(const bf16x8*)(proj + (size_t)tok * NPROJ + C_GQ + h * 64 + 16 * ks + 8 * hi);
#pragma unroll
    for (int sb = 0; sb < 2; ++sb)
#pragma unroll
        for (int ks = 0; ks < 4; ++ks) kf[sb][ks] = *(const bf16x8*)(proj + (size_t)(tok0 + 32 * sb + r32) * NPROJ + C_GK + h * 64 + 16 * ks + 8 * hi);
    const bf16_t* sp = (const bf16_t*)(p.ws + WS_SPT) + ((size_t)bh * 128 + n) * 8192;
#pragma unroll
    for (int vb = 0; vb < 4; ++vb)
#pragma unroll
        for (int ks = 0; ks < 4; ++ks) sf[vb][ks] = *(const bf16x8*)(sp + (32 * vb + r32) * 64 + 16 * ks + 8 * hi);
    u32x2 gwv[4][4];
#pragma unroll
    for (int vb = 0; vb < 4; ++vb)
#pragma unroll
        for (int g = 0; g < 4; ++g) gwv[vb][g] = *(const u32x2*)(proj + (size_t)tok * NPROJ + C_GR + h * 128 + 32 * vb + 8 * g + 4 * hi);
    stage_vT(proj, tok0, lds, tid);
    __syncthreads();
    f32x16 oT[4];
#pragma unroll
    for (int vb = 0; vb < 4; ++vb)
#pragma unroll
        for (int e = 0; e < 16; ++e) oT[vb][e] = 0.f;
#pragma unroll
    for (int vb = 0; vb < 4; ++vb)
#pragma unroll
        for (int ks = 0; ks < 4; ++ks) oT[vb] = __builtin_amdgcn_mfma_f32_32x32x16_bf16(sf[vb][ks], qf[ks], oT[vb], 0, 0, 0);
#pragma unroll
    for (int sb = 0; sb < 2; ++sb) {
        if (sb <= cb) {
        f32x16 X;
#pragma unroll
        for (int e = 0; e < 16; ++e) X[e] = 0.f;
#pragma unroll
        for (int ks = 0; ks < 4; ++ks) X = __builtin_amdgcn_mfma_f32_32x32x16_bf16(kf[sb][ks], qf[ks], X, 0, 0, 0);
        if (sb == cb) {
#pragma unroll
            for (int i = 0; i < 16; ++i) if (crow(i, hi) > r32) X[i] = 0.f; }
        bf16x8 xs[2];
#pragma unroll
        for (int s2 = 0; s2 < 2; ++s2) { u32x4 w;
#pragma unroll
            for (int e = 0; e < 4; ++e) w[e] = pk2(X[8 * s2 + 2 * e], X[8 * s2 + 2 * e + 1]);
            xs[s2] = __builtin_bit_cast(bf16x8, w); }
#pragma unroll
        for (int vb = 0; vb < 4; ++vb)
#pragma unroll
            for (int st = 0; st < 2; ++st) { const bf16x8 af = vs_frag(vT, 32 * sb + 16 * st + 4 * hi, 8, h * 128 + 32 * vb, lane);
                oT[vb] = __builtin_amdgcn_mfma_f32_32x32x16_bf16(af, xs[st], oT[vb], 0, 0, 0); }
        }
    }
    float ss = 0.f;
#pragma unroll
    for (int vb = 0; vb < 4; ++vb)
#pragma unroll
        for (int e = 0; e < 16; ++e) ss += oT[vb][e] * oT[vb][e];
    ss += __shfl_xor(ss, 32);
    const float rstd = rsqrtf(ss * (1.0f / 128.0f) + EPS);
    bf16_t* mix = (bf16_t*)(p.ws + WS_MIX);
#pragma unroll
    for (int vb = 0; vb < 4; ++vb)
#pragma unroll
        for (int g = 0; g < 4; ++g) { const int v0 = 32 * vb + 8 * g + 4 * hi;
            const u32x2 gw = gwv[vb][g];
            const f32x4 gn = *(const f32x4*)(p.gla_og + h * 128 + v0);
            float r[4] = {bflo(gw.x), bfhi(gw.x), bflo(gw.y), bfhi(gw.y)}; float ov[4];
#pragma unroll
            for (int e = 0; e < 4; ++e) { const float sg = r[e] / (1.0f + __expf(-r[e])); ov[e] = oT[vb][4 * g + e] * rstd * gn[e] * sg; }
            u32x2 w; w.x = pk2(ov[0], ov[1]); w.y = pk2(ov[2], ov[3]);
            *(u32x2*)(mix + (size_t)tok * DM + 512 + h * 128 + v0) = w; }
    __syncthreads();
}

#define XB_TMO      128
#define XB_XCNT(j)  (256  + 64 * (j))
#define XB_XSUB(j)  (1280 + 64 * (j))
#define XB_XGEN(j)  (2304 + 64 * (j))
#define XB_TOP      3328
#define XB_TOPGEN   3392
#define XCD_BAR_WORDS 3456
#define XB_SPIN_CAP (1u << 18)
DI unsigned xb_ld(unsigned* p)              { return __hip_atomic_load(p, __ATOMIC_RELAXED, __HIP_MEMORY_SCOPE_AGENT); }
DI unsigned xb_add(unsigned* p, unsigned v) { return __hip_atomic_fetch_add(p, v, __ATOMIC_RELAXED, __HIP_MEMORY_SCOPE_AGENT); }
DI unsigned xb_xcc_id() { return (unsigned)__builtin_amdgcn_s_getreg((3 << 11) | 20) & 0xFu; }
#define XB_SPIN(cond, bar) do { unsigned _sp = 0; while (cond) { __builtin_amdgcn_s_sleep(1); \
    if ((++_sp & 255u) == 0u) { if (xb_ld(&(bar)[XB_TMO])) break; if (_sp > XB_SPIN_CAP) { atomicAdd(&(bar)[XB_TMO], 1u); break; } } } } while (0)
struct XcdBarrier { unsigned* bar; unsigned x; volatile LAS unsigned* st; };
DI XcdBarrier xcd_barrier_post(unsigned* bar, volatile LAS unsigned* st) {
    XcdBarrier b; b.bar = bar; b.x = xb_xcc_id(); b.st = st;
    if (threadIdx.x == 0) (void)xb_add(&bar[XB_XCNT(b.x)], 1u);
    return b;
}
DI void xcd_barrier_complete(unsigned* bar, unsigned x, unsigned& nloc, unsigned& nx) {
    const unsigned G = gridDim.x * gridDim.y * gridDim.z;
    unsigned sum, cnt, mine, sp = 0u;
    for (;;) {
        sum = 0u; cnt = 0u; mine = 0u;
#pragma unroll
        for (unsigned j = 0; j < 16; ++j) { const unsigned c = xb_ld(&bar[XB_XCNT(j)]); sum += c; cnt += (c > 0u) ? 1u : 0u; mine = (j == x) ? c : mine; }
        if (sum == G) break;
        __builtin_amdgcn_s_sleep(1);
        if ((++sp & 255u) == 0u) { if (xb_ld(&bar[XB_TMO])) break; if (sp > XB_SPIN_CAP) { atomicAdd(&bar[XB_TMO], 1u); break; } }
    }
    nloc = mine > 0u ? mine : 1u; nx = cnt > 0u ? cnt : 1u;
}
DI void xcd_barrier(const XcdBarrier& b) {
    asm volatile("s_waitcnt vmcnt(0)" ::: "memory");
    __syncthreads();
    if (threadIdx.x == 0) {
        unsigned* bar = b.bar;
        __builtin_amdgcn_s_waitcnt(0);
        unsigned nloc = b.st[0], nx = b.st[1];
        if (nloc == 0u) { xcd_barrier_complete(bar, b.x, nloc, nx); b.st[0] = nloc; b.st[1] = nx; }
        const unsigned old = xb_add(&bar[XB_XSUB(b.x)], 1u);
        const unsigned gen = old / nloc;
        if (old + 1u == (gen + 1u) * nloc) {
            __builtin_amdgcn_fence(__ATOMIC_RELEASE, "agent");
            asm volatile("s_waitcnt vmcnt(0)" ::: "memory");
            const unsigned og = xb_add(&bar[XB_TOP], 1u);
            const unsigned tg = og / nx;
            if (og + 1u == (tg + 1u) * nx) xb_add(&bar[XB_TOPGEN], 1u);
            else XB_SPIN(xb_ld(&bar[XB_TOPGEN]) == tg, bar);
            __builtin_amdgcn_fence(__ATOMIC_ACQUIRE, "agent");
            xb_add(&bar[XB_XGEN(b.x)], 1u);
            asm volatile("s_waitcnt vmcnt(0)" ::: "memory");
        } else {
            XB_SPIN(xb_ld(&bar[XB_XGEN(b.x)]) == gen, bar);
            __builtin_amdgcn_fence(__ATOMIC_ACQUIRE, "agent");
            asm volatile("s_waitcnt vmcnt(0)" ::: "memory");
        }
    }
    __syncthreads();
}

__global__ void __launch_bounds__(512, 2) fwd_megakernel(Params p) {
    extern __shared__ __attribute__((aligned(16))) unsigned char lds_raw[];
    LAS unsigned char* lds = (LAS unsigned char*)lds_raw;
    cg::grid_group grid = cg::this_grid();
    const int G = gridDim.x, bx = blockIdx.x;
    unsigned char* ws = p.ws;
    bf16_t* proj = (bf16_t*)(ws + WS_PROJ);

    if (threadIdx.x < 2) ((volatile LAS unsigned*)(lds + MISC_OFF))[threadIdx.x] = 0u;
    __syncthreads();
    if (p.never) grid.sync();
    const XcdBarrier xbar = xcd_barrier_post((unsigned*)(ws + WS_BAR), (volatile LAS unsigned*)(lds + MISC_OFF));
#define GSYNC() xcd_barrier(xbar)
    for (int rep = 0; rep < (PROBE_ID == 3 ? 2 : 1); ++rep) { p0_prologue(p, lds, G); if (PROBE_ID == 3) GSYNC(); }
    GSYNC();
    if (PROBE_ID == 1) { for (int rep = 0; rep < 10; ++rep) GSYNC(); }
    for (int rep10 = 0; rep10 < (PROBE_ID == 10 ? 2 : 1); ++rep10) {
    for (int rep = 0; rep < (PROBE_ID == 2 ? 2 : 1); ++rep) {
    { pg8::Gemm g{(const bf16_t*)(ws + WS_XN), (const bf16_t*)(ws + WS_WIN)};
      pg8::StaticOrder S; S.init(MTOK, NPROJ, G, bx);
      pg8::EpiProj E{proj, (float*)(ws + WS_AUX), p.fox_q_g, p.fox_k_g};
      pg8::gemm_phase<pg8::GeoPlain<DM>>(lds, g, S, E); }
    { pg8::Gemm g{(const bf16_t*)(ws + WS_MEMN), (const bf16_t*)(ws + WS_WKV)};
      pg8::StaticOrder S; S.init(NBATCH * MEMLEN, 2 * DM, G, (bx + G / 2) % G);
      pg8::EpiNorm E{(bf16_t*)(ws + WS_KN), nullptr, p.xk_g, 1.0f, (bf16_t*)(ws + WS_VT)};
      pg8::gemm_phase<pg8::GeoPlain<DM>>(lds, g, S, E); }
    if (G == 256 && bx >= 160) { __syncthreads(); late_transposes(p, lds, (bx - 160) * 8 + (int)(threadIdx.x >> 6), (G - 160) * 8); }
    if (PROBE_ID == 2 && rep == 0) GSYNC(); }
    GSYNC();
    for (int c = bx; c < MTOK / 64; c += G) p2_unit(c, p, lds);
    GSYNC();
    }
    for (int rep = 0; rep < (PROBE_ID == 4 ? 2 : 1); ++rep) {
    { pg8::Gemm g{(const bf16_t*)(ws + WS_WO), (const bf16_t*)(ws + WS_VT)};
      pg8::StaticOrder S; S.init(DM, 4 * DM, G, (G == 256) ? ((((bx >> 3) & 7) <= 1) ? ((bx & 7) + 8 * ((bx >> 3) & 7) + 16 * (bx >> 6)) : 64 + bx) : bx);
      pg8::EpiBf<4 * DM, 0, false, -1> E{(bf16_t*)(ws + WS_VWT), nullptr, nullptr};
      pg8::gemm_phase<pg8::Geo<256, DM, DM, 256, 256, 0, 0, 2, 256L * DM>>(lds, g, S, E); }
    for (int r11 = 0; r11 < (PROBE_ID == 11 ? 2 : 1); ++r11) gla_scan(p, G, lds);
    { const int tl = get_tid() & 63; float gq = fabsf(p.fox_q_g[tl]), gk = fabsf(p.fox_k_g[tl]);
#pragma unroll
      for (int o = 1; o < 64; o <<= 1) { gq = fmaxf(gq, __shfl_xor(gq, o)); gk = fmaxf(gk, __shfl_xor(gk, o)); }
      const float bqk = 64.0f * gq * gk * 0.125f * LOG2E * 1.02f, thr2 = 150.0f + bqk;
      if (G == 256) { const int bh = (bx & 7) * 4 + (bx >> 6), j = (bx >> 3) & 7;
          fox_bh_setup(bh, p, lds);
          for (int i = 3; i >= 0; --i) fox_unit(bh, j + 8 * i, p, lds, thr2); }
      else { for (int u = bx; u < 1024; u += G) { fox_bh_setup(u >> 5, p, lds); fox_unit(u >> 5, u & 31, p, lds, thr2); } } }
    if (PROBE_ID == 4 && rep == 0) GSYNC(); }
    GSYNC();
    for (int rep = 0; rep < (PROBE_ID == 5 ? 2 : 1); ++rep) {
    for (int c = bx; c < MTOK / 64; c += G) gla_out_unit(c, p, lds);
    if (PROBE_ID == 5 && rep == 0) GSYNC(); }
    GSYNC();
    { pg8::Gemm g{(const bf16_t*)(ws + WS_MIX), (const bf16_t*)(ws + WS_WOUT)};
      pg8::StaticOrder S; S.init(MTOK, DM, G, bx);
      pg8::EpiRes<false, false, true> E{p.x, nullptr, (bf16_t*)(ws + WS_HB), (float*)(ws + WS_SUMSQ1)};
      pg8::gemm_phase<pg8::GeoPlain<DM>>(lds, g, S, E); }
    GSYNC();
    for (int rep = 0; rep < (PROBE_ID == 6 ? 2 : 1); ++rep) {
    { pg8::Gemm g{(const bf16_t*)(ws + WS_HB), (const bf16_t*)(ws + WS_WQ)};
      pg8::StaticOrder S; S.init(MTOK, DM, G, bx);
      pg8::EpiNorm E{(bf16_t*)(ws + WS_QN), (const float*)(ws + WS_SUMSQ1), p.xq_g, 1.0f / 16.0f, nullptr};
      pg8::gemm_phase<pg8::GeoPlain<DM>>(lds, g, S, E); }
    if (PROBE_ID == 6 && rep == 0) GSYNC(); }
    GSYNC();
    for (int rep = 0; rep < (PROBE_ID == 7 ? 2 : 1); ++rep) {
    { pg8::Gemm g{(const bf16_t*)(ws + WS_QN), (const bf16_t*)(ws + WS_KN)};
      pg8::StaticOrder S; S.init(MTOK, DM, G, bx);
      pg8::EpiSoftmax E{(bf16_t*)(ws + WS_P)};
      pg8::gemm_phase<pg8::Geo<256, DM, DM, 256, 256, 256L * DM, 5>>(lds, g, S, E); }
    if (PROBE_ID == 7 && rep == 0) GSYNC(); }
    GSYNC();
    { pg8::Gemm g{(const bf16_t*)(ws + WS_P), (const bf16_t*)(ws + WS_VWT)};
      pg8::StaticOrder S; S.init(MTOK, DM, G, bx);
      pg8::EpiRes<true, false, true> E{(const void*)(ws + WS_HB), nullptr, (bf16_t*)(ws + WS_HB), (float*)(ws + WS_SUMSQ2)};
      pg8::gemm_phase<pg8::Geo<DM, DM, 4 * DM, 0, 256L * 4 * DM, DM, 5>>(lds, g, S, E); }
    GSYNC();
    for (int rep = 0; rep < (PROBE_ID == 9 ? 2 : 1); ++rep) {
    { pg8::Gemm g{(const bf16_t*)(ws + WS_HB), (const bf16_t*)(ws + WS_W1)};
      pg8::StaticOrder S; S.init(MTOK, FF, G, bx);
      pg8::EpiBf<FF, 1, true, -1> E{(bf16_t*)(ws + WS_U), (const float*)(ws + WS_SUMSQ2), nullptr};
      pg8::gemm_phase<pg8::GeoPlain<DM>>(lds, g, S, E); }
    if (PROBE_ID == 9 && rep == 0) GSYNC(); }
    GSYNC();
    { pg8::Gemm g{(const bf16_t*)(ws + WS_U), (const bf16_t*)(ws + WS_W2)};
      pg8::StaticOrder S; S.init(MTOK, DM, G, bx);
      pg8::EpiRes<true, true, false> E{(const void*)(ws + WS_HB), p.out, nullptr, nullptr};
      pg8::gemm_phase<pg8::GeoPlain<FF>>(lds, g, S, E); }
}

extern "C" void kernel_launch(void* const* d_in, const int* in_sizes, int n_in, void* d_out, int out_size, void* d_ws, size_t ws_size, hipStream_t stream) {
    static int grid = 0;
    if (grid == 0) {
        int dev = 0, cus = 0, per_cu = 0;
        hipGetDevice(&dev);
        hipDeviceGetAttribute(&cus, hipDeviceAttributeMultiprocessorCount, dev);
        hipFuncSetAttribute((const void*)fwd_megakernel, hipFuncAttributeMaxDynamicSharedMemorySize, LDS_BYTES);
        hipOccupancyMaxActiveBlocksPerMultiprocessor(&per_cu, (const void*)fwd_megakernel, 512, LDS_BYTES);
        if (per_cu < 1) { fprintf(stderr, "kernel_launch: occupancy query reports %d blocks per CU\n", per_cu); per_cu = 1; }
        if (per_cu > 1) per_cu = 1;
        grid = cus * per_cu;
        if (ws_size < WS_END) { fprintf(stderr, "kernel_launch: workspace too small (%zu < %zu)\n", ws_size, (size_t)WS_END); grid = -1; }
    }
    if (grid < 0) return;
    Params p{};
    const float** pp = (const float**)&p;
    for (int i = 0; i < 21; ++i) pp[i] = (const float*)d_in[i];
    p.out = (float*)d_out; p.ws = (unsigned char*)d_ws;
    p.never = 0;
    if (hipMemsetAsync((char*)d_ws + WS_BAR, 0, XCD_BAR_WORDS * 4, stream) != hipSuccess) { fprintf(stderr, "kernel_launch: memset of the barrier words failed\n"); return; }
    void* args[] = {&p};
    hipError_t e = hipLaunchCooperativeKernel((const void*)fwd_megakernel, dim3(grid), dim3(512), args, LDS_BYTES, stream);
    if (e != hipSuccess) fprintf(stderr, "cooperative launch failed: %s (grid %d)\n", hipGetErrorString(e), grid);
}
```
